# Optimizing an MI355X kernel written in HIP

```python
import math
import jax, jax.numpy as jnp
from jax import lax
import numpy as np

D_MODEL = 1024
BATCH = 32
SEQ = 2048
DEPTH = 1

N_HEADS = 16
N_KV_HEADS = 2
GROUP = N_HEADS // N_KV_HEADS
HEAD_DIM = 64
WINDOW = 128
BLOCK = 128
ATTN_SCALE = 1.0 / math.sqrt(HEAD_DIM)
NEG_INF = -1e30
POOL_WINDOWS = (2, 4, 8, 16)
N_POOL_GROUPS = len(POOL_WINDOWS)
POOL_GROUP = 128
POOL_W = N_POOL_GROUPS * POOL_GROUP
Q_W = N_HEADS * HEAD_DIM
KV_W = N_KV_HEADS * HEAD_DIM
IN_W = Q_W + 2 * KV_W + POOL_W + 2 * D_MODEL
SPLITS = (Q_W, Q_W + KV_W, Q_W + 2 * KV_W, Q_W + 2 * KV_W + POOL_W, Q_W + 2 * KV_W + POOL_W + D_MODEL)
PEER_HEADS = 8
N_KEYS = 128
N_EXPERTS = N_KEYS * N_KEYS
D_KEY = 256
D_HALF = D_KEY // 2
PEER_TOPK = 16
PEER_CHUNK = 128
EPS = 1e-5

kernel_name = 'hybrid_swa_pool_peer_block'


def rmsnorm(x, g):
    xf = x.astype(jnp.float32)
    y = xf * lax.rsqrt(jnp.mean(xf * xf, axis=-1, keepdims=True) + EPS)
    return (y * g.astype(jnp.float32)).astype(x.dtype)


def sliding_window_attention(q, k, v, sinks):
    b, s = q.shape[0], q.shape[1]
    nblk = s // BLOCK
    kp = jnp.pad(k, ((0, 0), (BLOCK, 0), (0, 0), (0, 0)))
    vp = jnp.pad(v, ((0, 0), (BLOCK, 0), (0, 0), (0, 0)))
    qb = q.reshape(b, nblk, BLOCK, N_KV_HEADS, GROUP, HEAD_DIM).swapaxes(0, 1)
    sink = sinks.astype(jnp.float32).reshape(1, N_KV_HEADS, GROUP, 1, 1)

    def one_block(args):
        i, qi = args
        start = i * BLOCK
        kb = lax.dynamic_slice_in_dim(kp, start, 2 * BLOCK, axis=1)
        vb = lax.dynamic_slice_in_dim(vp, start, 2 * BLOCK, axis=1)
        sc = jnp.einsum('bqhgd,bkhd->bhgqk', qi, kb).astype(jnp.float32) * ATTN_SCALE
        qpos = start + jnp.arange(BLOCK)
        kpos = start - BLOCK + jnp.arange(2 * BLOCK)
        rel = qpos[:, None] - kpos[None, :]
        mask = (rel >= 0) & (rel < WINDOW) & (kpos[None, :] >= 0)
        sc = jnp.where(mask, sc, NEG_INF)
        sc = jnp.concatenate([sc, jnp.broadcast_to(sink, sc.shape[:-1] + (1,))], axis=-1)
        p = jax.nn.softmax(sc, axis=-1)[..., :-1]
        return jnp.einsum('bhgqk,bkhd->bqhgd', p.astype(vb.dtype), vb)

    o = lax.map(one_block, (jnp.arange(nblk), qb))
    return o.swapaxes(0, 1).reshape(b, s, Q_W)


def multiscale_pool(p, w_grp, scale):
    b, s = p.shape[0], p.shape[1]
    pf = p.astype(jnp.float32).reshape(b, s, N_POOL_GROUPS, POOL_GROUP)
    c = jnp.cumsum(pf, axis=1)
    t1 = jnp.arange(1, s + 1, dtype=jnp.float32)
    outs = []
    for j, w in enumerate(POOL_WINDOWS):
        cj = c[:, :, j]
        lag = jnp.pad(cj, ((0, 0), (w, 0), (0, 0)))[:, :s]
        cnt = jnp.minimum(t1, float(w))[None, :, None]
        outs.append((cj - lag) / cnt - pf[:, :, j])
    pooled = jnp.stack(outs, axis=2).astype(p.dtype)
    y = jnp.einsum('bsgc,gcd->bsgd', pooled, w_grp).reshape(b, s, POOL_W)
    return y * scale


def peer(xn, w_query, sub_keys, u_tab, v_tab):
    b, s, d = xn.shape
    xt = xn.reshape((b * s) // PEER_CHUNK, PEER_CHUNK, d)

    def chunk(xc):
        c = xc.shape[0]
        q = (xc @ w_query).reshape(c, PEER_HEADS, 2, D_HALF)
        sc = jnp.einsum('chpd,hpkd->chpk', q, sub_keys).astype(jnp.float32)
        sv, si = lax.top_k(sc, PEER_TOPK)
        cand = (sv[:, :, 0, :, None] + sv[:, :, 1, None, :]).reshape(c, PEER_HEADS, PEER_TOPK * PEER_TOPK)
        cidx = (si[:, :, 0, :, None] * N_KEYS + si[:, :, 1, None, :]).reshape(c, PEER_HEADS, PEER_TOPK * PEER_TOPK)
        fv, fi = lax.top_k(cand, PEER_TOPK)
        idx = jnp.take_along_axis(cidx, fi, axis=-1)
        g = jax.nn.softmax(fv, axis=-1)
        u = u_tab[idx]
        a = jax.nn.gelu(jnp.einsum('chkd,cd->chk', u, xc).astype(jnp.float32), approximate=False)
        vv = v_tab[idx]
        return jnp.einsum('chk,chkd->cd', (g * a).astype(vv.dtype), vv)

    return lax.map(chunk, xt).reshape(b, s, d)


def setup_inputs(seed: int = 0) -> dict:
    key = jax.random.key(seed)
    ks = jax.random.split(key, 16)
    f32 = jnp.float32
    L = DEPTH
    nrm = lambda k, shape, std: jax.random.normal(k, shape, f32) * std
    return {
        'x': jax.random.normal(ks[0], (BATCH, SEQ, D_MODEL), f32),
        'ln_mix_g': 1.0 + nrm(ks[1], (L, D_MODEL), 0.05),
        'w_in': nrm(ks[2], (L, D_MODEL, IN_W), D_MODEL ** -0.5),
        'b_in': nrm(ks[3], (L, IN_W), 0.02),
        'attn_sinks': nrm(ks[4], (L, N_HEADS), 0.5),
        'w_attn_up': nrm(ks[5], (L, Q_W, D_MODEL), Q_W ** -0.5),
        'w_pool_grp': nrm(ks[6], (L, N_POOL_GROUPS, POOL_GROUP, POOL_GROUP), POOL_GROUP ** -0.5),
        'pool_scale': 1.0 + nrm(ks[7], (L, POOL_W), 0.1),
        'w_pool_up': nrm(ks[8], (L, POOL_W, D_MODEL), POOL_W ** -0.5),
        'w_o': nrm(ks[9], (L, D_MODEL, D_MODEL), D_MODEL ** -0.5),
        'ln_ffn_g': 1.0 + nrm(ks[10], (L, D_MODEL), 0.05),
        'w_query': nrm(ks[11], (L, D_MODEL, PEER_HEADS * D_KEY), D_MODEL ** -0.5),
        'sub_keys': nrm(ks[12], (L, PEER_HEADS, 2, N_KEYS, D_HALF), D_HALF ** -0.5),
        'u_experts': nrm(ks[13], (L, N_EXPERTS, D_MODEL), D_MODEL ** -0.5),
        'v_experts': nrm(ks[14], (L, N_EXPERTS, D_MODEL), PEER_HEADS ** -0.5),
        'ln_final_g': 1.0 + nrm(ks[15], (D_MODEL,), 0.05),
    }


def reference(x, ln_mix_g, w_in, b_in, attn_sinks, w_attn_up, w_pool_grp, pool_scale, w_pool_up, w_o,
              ln_ffn_g, w_query, sub_keys, u_experts, v_experts, ln_final_g):
    b, s, _ = x.shape
    h = x
    for l in range(DEPTH):
        xn = rmsnorm(h, ln_mix_g[l])
        z = xn @ w_in[l] + b_in[l]
        q, k, v, pz, ga, gp = jnp.split(z, SPLITS, axis=-1)
        q = q.reshape(b, s, N_KV_HEADS, GROUP, HEAD_DIM)
        k = k.reshape(b, s, N_KV_HEADS, HEAD_DIM)
        v = v.reshape(b, s, N_KV_HEADS, HEAD_DIM)
        y_a = sliding_window_attention(q, k, v, attn_sinks[l]) @ w_attn_up[l]
        y_p = multiscale_pool(pz, w_pool_grp[l], pool_scale[l]) @ w_pool_up[l]
        merged = jax.nn.sigmoid(ga) * y_a + jax.nn.sigmoid(gp) * y_p
        h = h + merged @ w_o[l]
        h = h + peer(rmsnorm(h, ln_ffn_g[l]), w_query[l], sub_keys[l], u_experts[l], v_experts[l])
    return rmsnorm(h, ln_final_g)
```

```cpp
#include <hip/hip_runtime.h>
#include <hip/hip_cooperative_groups.h>
#include <cstdio>
#include <cstdint>
namespace cg = cooperative_groups;

#define GAS __attribute__((address_space(1)))
#define LAS __attribute__((address_space(3)))
typedef unsigned short bf16_t;
typedef short bf16x8 __attribute__((ext_vector_type(8)));
typedef float f32x4 __attribute__((ext_vector_type(4)));
typedef float f32x16 __attribute__((ext_vector_type(16)));
typedef unsigned u32x4 __attribute__((ext_vector_type(4)));
typedef unsigned u32x2 __attribute__((ext_vector_type(2)));
typedef float f32x2_t __attribute__((ext_vector_type(2)));
typedef __bf16 bf16x2_t __attribute__((ext_vector_type(2)));

__device__ __forceinline__ unsigned cvtpk(float lo, float hi) { f32x2_t v = {lo, hi}; bf16x2_t b = __builtin_convertvector(v, bf16x2_t); return __builtin_bit_cast(unsigned, b); }
__device__ __forceinline__ float bf_lo(unsigned d) { return __uint_as_float(d << 16); }
__device__ __forceinline__ float bf_hi(unsigned d) { return __uint_as_float(d & 0xffff0000u); }
__device__ __forceinline__ float dot2bf(unsigned a, unsigned b, float c) { return __builtin_amdgcn_fdot2_f32_bf16(__builtin_bit_cast(bf16x2_t, a), __builtin_bit_cast(bf16x2_t, b), c, false); }
__device__ __forceinline__ unsigned fp8x2_to_bf16x2(unsigned s, bool hi) { return hi ? __builtin_bit_cast(unsigned, __builtin_amdgcn_cvt_scalef32_pk_bf16_fp8(s, 1.0f, true)) : __builtin_bit_cast(unsigned, __builtin_amdgcn_cvt_scalef32_pk_bf16_fp8(s, 1.0f, false)); }
__device__ __forceinline__ float wave_sum(float v) {
#pragma unroll
    for (int o = 1; o < 64; o <<= 1) v += __shfl_xor(v, o);
    return v;
}

constexpr int T = 65536, D = 1024, SEQ = 2048, NB = 32;
constexpr int INW = 3840, NEXP = 16384;
constexpr float EPS = 1e-5f;
constexpr float LOG2E = 1.4426950408889634f;
constexpr float QSCALE = 0.125f * LOG2E;
constexpr float MRG_SCALE = 16.f, W8_SCALE = 64.f;

constexpr size_t MiB = 1u << 20;
constexpr size_t WS_CTL = 0;
constexpr size_t WS_WIN = 1 * MiB;
constexpr size_t WS_WUP = 9 * MiB;
constexpr size_t WS_WPU = 11 * MiB;
constexpr size_t WS_WO = 12 * MiB;
constexpr size_t WS_WQC = 56 * MiB;
constexpr size_t WS_SK = 18 * MiB;
constexpr size_t WS_SCU = 19 * MiB;
constexpr size_t WS_SCV = 19 * MiB + 65536;
constexpr size_t WS_U = 32 * MiB;
constexpr size_t WS_V = 64 * MiB;
constexpr size_t WS_XN = 96 * MiB;
constexpr size_t WS_Q = 224 * MiB;
constexpr size_t WS_AO = 352 * MiB;
constexpr size_t WS_KV = 480 * MiB;
constexpr size_t WS_PZ = 512 * MiB;
constexpr size_t WS_PL = 576 * MiB;
constexpr size_t WS_H = 480 * MiB;
constexpr size_t WS_SGA = 640 * MiB;
constexpr size_t WS_SGP = 768 * MiB;
constexpr size_t WS_EID = 768 * MiB;
constexpr size_t WS_GSM = 800 * MiB;
constexpr size_t WS_GS8 = 816 * MiB;
constexpr size_t WS_WSC = 832 * MiB;
constexpr size_t WS_WIN8 = 24 * MiB;
constexpr size_t WS_SWIN = 28 * MiB;
constexpr size_t WS_WQ8 = 29 * MiB;
constexpr size_t WS_SWQ = 31 * MiB;
constexpr size_t WS_XH8 = 224 * MiB;
constexpr size_t WS_XS0 = 21 * MiB + 512 * 1024;
constexpr size_t WS_X8 = 896 * MiB;
constexpr size_t WS_XS = 20 * MiB;
constexpr size_t WS_END = 1024 * MiB;

constexpr int LDS_BYTES = 163840;

namespace pg8 {
typedef int i32x4_t __attribute__((ext_vector_type(4))); typedef int i32x8_t __attribute__((ext_vector_type(8)));
constexpr int BM = 256, BK = 64, HALF = 128, HTB = HALF * BK * 2, STAGE_BYTES = 8 * HTB, NXCD = 8, WGM = 8;
__host__ __device__ __forceinline__ int lds_byte(int r, int c) { const int st = (r >> 4) * 2 + (c >> 5), rr = r & 15, cc = c & 31, ob = rr * 64 + cc * 2; return st * 1024 + (ob ^ (((ob >> 9) & 1) << 5)); }
__host__ __device__ __forceinline__ void stage_rc(int b, int& R, int& C) { const int st = b / 1024, sb = b % 1024, swz = sb ^ (((sb >> 9) & 1) << 5); R = (st >> 1) * 16 + swz / 64; C = (st & 1) * 32 + (swz % 64) / 2; }
__host__ __device__ __forceinline__ int perm32(int rho) { const int n = rho >> 4, i = rho & 15; return 8 * (i >> 2) + 4 * n + (i & 3); }
struct Unit { int pm, pn, kofs, nt, seg; };
struct Gemm { const bf16_t* A; const bf16_t* Bt; int M, N, K; };
struct StaticOrder {
    int nM, nN, nwg, G, c, rep, nun, nseg, k0, k1, esz;
    __host__ __device__ void init(int M, int N, int G_, int c_, int rep_ = 1, int K0 = 0, int K1 = 0, int esz_ = 2) { nM = M / BM; nN = N / BM; nwg = nM * nN; G = G_; c = c_; rep = rep_; nun = (nwg - c + G - 1) / G; nseg = K1 ? 2 : 1; k0 = K0; k1 = K1; esz = esz_; }
    __host__ __device__ bool next(int i, Unit& u) const {
        const int iu = i / nseg, sg = i - iu * nseg;
        if (iu >= rep * nun) return false;
        const long L = (long)(iu % nun) * G + c; if (L >= nwg) return false;
        int wgid = (int)L; { const int q = nwg / NXCD, r = nwg % NXCD, xcd = wgid % NXCD, off = wgid / NXCD; wgid = (xcd < r ? xcd * (q + 1) : r * (q + 1) + (xcd - r) * q) + off; }
        const int nig = WGM * nN, gid = wgid / nig, fm = gid * WGM, gsz = (nM - fm) < WGM ? (nM - fm) : WGM;
        u.pm = fm + ((wgid % nig) % gsz); u.pn = (wgid % nig) / gsz;
        u.seg = sg; u.kofs = sg ? k0 * esz : 0; u.nt = ((sg ? k1 : k0) * esz) / (BK * 2); return true;
    }
    __device__ __forceinline__ void a_ready(const Unit&) const {}
    __device__ __forceinline__ void done(const Unit&) const {}
};
struct NoPre {};
template <class F> struct Epi8 {
    static constexpr bool PERM = true, AFTER_DRAIN = false;
    F f;
    __device__ __forceinline__ bool operator()(f32x4 (&acc)[2][2][4][2], const Unit& u, int wr, int wc, int fr, int fq) const {
        const int row0 = u.pm * BM + wr * 64 + fr, col0 = u.pn * BM + wc * 32 + 8 * fq;
        const bool seam = F::SEGS == 2 && u.seg == 0;
        typename F::TilePre tp; f.tile_preload(row0, col0, u.pn, tp);
#pragma unroll
        for (int ai = 0; ai < 2; ++ai) {
            typename F::Pre pre[4][2];
            float rs4[4] = {1.f, 1.f, 1.f, 1.f};
            if constexpr (F::IACC) {
#pragma unroll
                for (int m = 0; m < 4; ++m) rs4[m] = f.row_scale(row0 + ai * HALF + m * 16);
            }
#pragma unroll
            for (int m = 0; m < 4; ++m)
#pragma unroll
                for (int bj = 0; bj < 2; ++bj) { if (seam) f.preload_seam(row0 + ai * HALF + m * 16, col0 + bj * HALF, pre[m][bj]); else f.preload(row0 + ai * HALF + m * 16, col0 + bj * HALF, pre[m][bj]); }
#pragma unroll
            for (int m = 0; m < 4; ++m)
#pragma unroll
                for (int bj = 0; bj < 2; ++bj) {
                    if (F::PAIRED && bj == 1) continue;
                    const f32x4 a = acc[ai][bj][m][0], b = acc[ai][bj][m][1];
                    float v[8] = {a[0], a[1], a[2], a[3], b[0], b[1], b[2], b[3]};
                    if (F::PAIRED) { const f32x4 a1 = acc[ai][1][m][0], b1 = acc[ai][1][m][1]; float v1[8] = {a1[0], a1[1], a1[2], a1[3], b1[0], b1[1], b1[2], b1[3]};
                        if constexpr (F::IACC) { const float rs = rs4[m];
#pragma unroll
                            for (int i = 0; i < 8; ++i) { v[i] = (float)__float_as_int(v[i]) * rs; v1[i] = (float)__float_as_int(v1[i]) * rs; } }
                        f.pair(row0 + ai * HALF + m * 16, col0, u.pn, v, v1, tp); continue; }
                    if (seam) { f.seam(row0 + ai * HALF + m * 16, col0 + bj * HALF, v, pre[m][bj]); acc[ai][bj][m][0] = (f32x4){v[0], v[1], v[2], v[3]}; acc[ai][bj][m][1] = (f32x4){v[4], v[5], v[6], v[7]}; }
                    else { if constexpr (F::IACC) {
#pragma unroll
                               for (int i = 0; i < 8; ++i) v[i] = (float)__float_as_int(v[i]) * rs4[m]; }
                           f(row0 + ai * HALF + m * 16, col0 + bj * HALF, u.pn, v, pre[m][bj], tp, bj); }
                }
        }
        return !seam;
    }
};

template <class Epi, class Sched, bool ALIGN_EPI = false, bool SP2 = false, int ESZ = 2, bool I8 = false>
__device__ __forceinline__ void gemm_phase(LAS unsigned char* lds, const Gemm g, const Sched& S, const Epi& E) {
    int tid = threadIdx.x; asm volatile("" : "+v"(tid));
    const int wid = __builtin_amdgcn_readfirstlane(tid >> 6), lane = tid & 63, wr = wid >> 2, wc = wid & 3, fr = lane & 15, fq = lane >> 4;
    const int K = g.K;
    unsigned voffA[2], voffB[2];
#pragma unroll
    for (int i = 0; i < 2; ++i) { int R, C; stage_rc(tid * 16 + i * 8192, R, C); const int Rb = Epi::PERM ? ((R & ~31) + perm32(R & 31)) : R;
        voffA[i] = (unsigned)(R * K * ESZ + C * 2); voffB[i] = (unsigned)(Rb * K * ESZ + C * 2); }
    const size_t kstep = (size_t)(BK * 2);
    const size_t hstep = (size_t)HALF * K * ESZ;
    const size_t tstep = 2 * hstep;
    const unsigned ldsw = (unsigned)wid * 1024u;
    const int aoff = lds_byte(wr * 64 + fr, fq * 8), boff = lds_byte(wc * 32 + fr, fq * 8);
#define PG8_SA(b, h) (((b) * 2 + (h)) * HTB)
#define PG8_SB(b, h) ((4 + (b) * 2 + (h)) * HTB)
#define PG8_STAGE(bufoff, gbase, voff) do { _Pragma("unroll") for (int _i = 0; _i < 2; ++_i) \
        __builtin_amdgcn_global_load_lds((const unsigned*)((const char*)(gbase) + (voff)[_i]), (LAS unsigned*)(lds + (bufoff) + ldsw + _i * 8192), 16, 0, 0); } while (0)
#define PG8_LDA(dst, b, h) do { _Pragma("unroll") for (int m = 0; m < 4; ++m) { dst[m].lo = *(const LAS i32x4_t*)(lds + PG8_SA(b, h) + aoff + m * 2048); dst[m].hi = *(const LAS i32x4_t*)(lds + PG8_SA(b, h) + aoff + m * 2048 + 1024); } } while (0)
#define PG8_LDB(dst, b, h) do { _Pragma("unroll") for (int n = 0; n < 2; ++n) { dst[n].lo = *(const LAS i32x4_t*)(lds + PG8_SB(b, h) + boff + n * 2048); dst[n].hi = *(const LAS i32x4_t*)(lds + PG8_SB(b, h) + boff + n * 2048 + 1024); } } while (0)
#define PG8_MMA(ai, bj, At, Bt) do { __builtin_amdgcn_s_setprio(1); _Pragma("unroll") for (int m = 0; m < 4; ++m) _Pragma("unroll") for (int n = 0; n < 2; ++n) { \
        if constexpr (ESZ == 1 && !I8) asm volatile("v_mfma_scale_f32_16x16x128_f8f6f4 %0, %1, %2, %0, %3, %3 op_sel_hi:[0,0,0]" : "+v"(acc[ai][bj][m][n]) : "v"(Bt[n]), "v"(At[m]), "v"(f8one));     \
        else if constexpr (I8) { const i32x4_t bl_ = Bt[n].lo, bh_ = Bt[n].hi, al_ = At[m].lo, ah_ = At[m].hi; const f32x4 t_ = acc[ai][bj][m][n]; i32x4_t c_ = __builtin_bit_cast(i32x4_t, t_);     \
               c_ = __builtin_amdgcn_mfma_i32_16x16x64_i8(bl_, al_, c_, 0, 0, 0); c_ = __builtin_amdgcn_mfma_i32_16x16x64_i8(bh_, ah_, c_, 0, 0, 0); acc[ai][bj][m][n] = __builtin_bit_cast(f32x4, c_); } \
        else { const i32x4_t bl_ = Bt[n].lo, bh_ = Bt[n].hi, al_ = At[m].lo, ah_ = At[m].hi;     \
               acc[ai][bj][m][n] = __builtin_amdgcn_mfma_f32_16x16x32_bf16(__builtin_bit_cast(bf16x8, bl_), __builtin_bit_cast(bf16x8, al_), acc[ai][bj][m][n], 0, 0, 0); \
               acc[ai][bj][m][n] = __builtin_amdgcn_mfma_f32_16x16x32_bf16(__builtin_bit_cast(bf16x8, bh_), __builtin_bit_cast(bf16x8, ah_), acc[ai][bj][m][n], 0, 0, 0); } } \
        if constexpr (ESZ == 1 && !I8) asm volatile("s_nop 7" ::: "memory"); __builtin_amdgcn_s_setprio(0); } while (0)
#define PG8_WAIT_V(n) asm volatile("s_waitcnt vmcnt(" #n ")" ::: "memory")
#define PG8_WAIT_L(n) asm volatile("s_waitcnt lgkmcnt(" #n ")" ::: "memory")
#define PG8_BAR __builtin_amdgcn_s_barrier()
#define PG8_SCHED __builtin_amdgcn_sched_barrier(0)
    Unit cur, nxt; int ui = 0;
    if (!S.next(0, cur)) return;
    f32x4 acc[2][2][4][2];
#pragma unroll
    for (int a = 0; a < 2; ++a)
#pragma unroll
        for (int b = 0; b < 2; ++b)
#pragma unroll
            for (int m = 0; m < 4; ++m)
#pragma unroll
                for (int n = 0; n < 2; ++n) acc[a][b][m][n] = (f32x4){0.f, 0.f, 0.f, 0.f};
    int f8one = 0x7f7f7f7f; if constexpr (ESZ == 1 && !I8) asm volatile("" : "+v"(f8one));
    i32x8_t At[4], B0[2], B1[2];
    const char* cA = (const char*)g.A + (size_t)cur.pm * tstep + cur.kofs; const char* cB = (const char*)g.Bt + (size_t)cur.pn * tstep + cur.kofs;
    S.a_ready(cur);
    if constexpr (SP2) {
        PG8_STAGE(PG8_SB(0, 0), cB, voffB); PG8_STAGE(PG8_SB(0, 1), cB + hstep, voffB); PG8_STAGE(PG8_SA(0, 0), cA, voffA); PG8_STAGE(PG8_SA(0, 1), cA + hstep, voffA);
        if (wr == 1) PG8_BAR;
        PG8_WAIT_V(2); PG8_BAR;
        PG8_STAGE(PG8_SB(1, 0), cB + kstep, voffB); PG8_STAGE(PG8_SA(1, 0), cA + kstep, voffA); PG8_STAGE(PG8_SB(1, 1), cB + hstep + kstep, voffB);
        PG8_WAIT_V(6); PG8_BAR;
    } else {
        PG8_STAGE(PG8_SB(0, 0), cB, voffB); PG8_STAGE(PG8_SA(0, 0), cA, voffA); PG8_STAGE(PG8_SB(0, 1), cB + hstep, voffB); PG8_STAGE(PG8_SA(0, 1), cA + hstep, voffA);
        if (wr == 1) PG8_BAR;
        PG8_WAIT_V(4); PG8_BAR;
        PG8_STAGE(PG8_SB(1, 0), cB + kstep, voffB); PG8_STAGE(PG8_SA(1, 0), cA + kstep, voffA); PG8_STAGE(PG8_SB(1, 1), cB + hstep + kstep, voffB);
        PG8_WAIT_V(6); PG8_BAR;
    }
    for (;;) {
        const bool has_next = S.next(ui + 1, nxt);
        const char* nA = has_next ? (const char*)g.A + (size_t)nxt.pm * tstep + nxt.kofs : cA; const char* nB = has_next ? (const char*)g.Bt + (size_t)nxt.pn * tstep + nxt.kofs : cB;
        const int nt = cur.nt;
        for (int t = 0; t < nt; t += 2) {
            const bool last = (t == nt - 2);
            const char* a1 = cA + (size_t)(t + 1) * kstep;
            const char* a2 = last ? nA : cA + (size_t)(t + 2) * kstep; const char* b2 = last ? nB : cB + (size_t)(t + 2) * kstep;
            const char* a3 = a2 + kstep; const char* b3 = b2 + kstep;
            if (last && has_next) S.a_ready(nxt);
            if constexpr (SP2) {
            PG8_LDB(B0, 0, 0); PG8_LDB(B1, 0, 1); PG8_SCHED; PG8_LDA(At, 0, 0); PG8_STAGE(PG8_SA(1, 1), a1 + hstep, voffA);
            PG8_WAIT_V(8); PG8_WAIT_L(0); PG8_BAR; PG8_MMA(0, 0, At, B0); PG8_MMA(0, 1, At, B1); PG8_BAR; PG8_SCHED;
            PG8_LDA(At, 0, 1); PG8_STAGE(PG8_SB(0, 0), b2, voffB); PG8_STAGE(PG8_SB(0, 1), b2 + hstep, voffB); PG8_STAGE(PG8_SA(0, 0), a2, voffA);
            PG8_WAIT_V(8); PG8_WAIT_L(0); PG8_BAR; PG8_MMA(1, 0, At, B0); PG8_MMA(1, 1, At, B1); PG8_BAR; PG8_SCHED;
            PG8_LDB(B0, 1, 0); PG8_LDB(B1, 1, 1); PG8_SCHED; PG8_LDA(At, 1, 0); PG8_STAGE(PG8_SA(0, 1), a2 + hstep, voffA);
            PG8_WAIT_V(8); PG8_WAIT_L(0); PG8_BAR; PG8_MMA(0, 0, At, B0); PG8_MMA(0, 1, At, B1); PG8_BAR; PG8_SCHED;
            PG8_LDA(At, 1, 1); PG8_STAGE(PG8_SB(1, 0), b3, voffB); PG8_STAGE(PG8_SB(1, 1), b3 + hstep, voffB); PG8_STAGE(PG8_SA(1, 0), a3, voffA);
            PG8_WAIT_V(8); PG8_WAIT_L(0); PG8_BAR; PG8_MMA(1, 0, At, B0); PG8_MMA(1, 1, At, B1); PG8_BAR; PG8_SCHED;
            } else {
            PG8_LDB(B0, 0, 0); PG8_SCHED; PG8_LDA(At, 0, 0); PG8_STAGE(PG8_SA(1, 1), a1 + hstep, voffA);
            PG8_WAIT_L(8); PG8_BAR; PG8_WAIT_L(0); PG8_MMA(0, 0, At, B0); PG8_BAR; PG8_SCHED;
            PG8_LDB(B1, 0, 1); PG8_STAGE(PG8_SB(0, 0), b2, voffB);
            PG8_BAR; PG8_WAIT_L(0); PG8_MMA(0, 1, At, B1); PG8_BAR;
            PG8_LDA(At, 0, 1); PG8_STAGE(PG8_SA(0, 0), a2, voffA);
            PG8_BAR; PG8_WAIT_L(0); PG8_MMA(1, 0, At, B0); PG8_BAR; PG8_SCHED;
            PG8_STAGE(PG8_SB(0, 1), b2 + hstep, voffB);
            PG8_WAIT_V(6); PG8_BAR; PG8_MMA(1, 1, At, B1); PG8_BAR;
            PG8_LDB(B0, 1, 0); PG8_SCHED; PG8_LDA(At, 1, 0); PG8_STAGE(PG8_SA(0, 1), a2 + hstep, voffA);
            PG8_WAIT_L(8); PG8_BAR; PG8_WAIT_L(0); PG8_MMA(0, 0, At, B0); PG8_BAR; PG8_SCHED;
            PG8_LDB(B1, 1, 1); PG8_STAGE(PG8_SB(1, 0), b3, voffB);
            PG8_BAR; PG8_WAIT_L(0); PG8_MMA(0, 1, At, B1); PG8_BAR;
            PG8_LDA(At, 1, 1); PG8_STAGE(PG8_SA(1, 0), a3, voffA);
            PG8_BAR; PG8_WAIT_L(0); PG8_MMA(1, 0, At, B0); PG8_BAR; PG8_SCHED;
            PG8_STAGE(PG8_SB(1, 1), b3 + hstep, voffB);
            PG8_WAIT_V(6); PG8_BAR; PG8_MMA(1, 1, At, B1); PG8_BAR;
            }
        }
        if constexpr (ALIGN_EPI) { if (wr == 0) PG8_BAR; }
        if constexpr (ESZ == 1 && !I8) asm volatile("s_nop 15\n\ts_nop 15" ::: "memory");
        bool restart = true;
        if constexpr (!Epi::AFTER_DRAIN) { restart = E(acc, cur, wr, wc, fr, fq); S.done(cur); }
        if (!has_next) break;
        if (restart) {
#pragma unroll
        for (int a = 0; a < 2; ++a)
#pragma unroll
            for (int b = 0; b < 2; ++b)
#pragma unroll
                for (int m = 0; m < 4; ++m)
#pragma unroll
                    for (int n = 0; n < 2; ++n) acc[a][b][m][n] = (f32x4){0.f, 0.f, 0.f, 0.f};
        }
        cur = nxt; cA = nA; cB = nB; ++ui;
        if constexpr (ALIGN_EPI) { if (wr == 1) PG8_BAR; }
    }
    PG8_WAIT_V(0);
    if constexpr (!ALIGN_EPI) { if (wr == 0) PG8_BAR; }
    PG8_BAR;
#undef PG8_SA
#undef PG8_SB
#undef PG8_STAGE
#undef PG8_LDA
#undef PG8_LDB
#undef PG8_MMA
#undef PG8_WAIT_V
#undef PG8_WAIT_L
#undef PG8_BAR
#undef PG8_SCHED
}
}

__device__ __forceinline__ float sigmoidf_(float v) { return __builtin_amdgcn_rcpf(1.f + __builtin_amdgcn_exp2f(-v * LOG2E)); }
__device__ __forceinline__ u32x4 pack8(const float (&v)[8]) { u32x4 w; w.x = cvtpk(v[0], v[1]); w.y = cvtpk(v[2], v[3]); w.z = cvtpk(v[4], v[5]); w.w = cvtpk(v[6], v[7]); return w; }
__device__ __forceinline__ u32x2 pack8_fp8(const float (&v)[8], float sc) {
    float c[8];
#pragma unroll
    for (int i = 0; i < 8; ++i) c[i] = __builtin_amdgcn_fmed3f(v[i] * sc, -448.f, 448.f);
    int lo = 0, hi = 0;
    lo = __builtin_amdgcn_cvt_pk_fp8_f32(c[0], c[1], lo, false); lo = __builtin_amdgcn_cvt_pk_fp8_f32(c[2], c[3], lo, true);
    hi = __builtin_amdgcn_cvt_pk_fp8_f32(c[4], c[5], hi, false); hi = __builtin_amdgcn_cvt_pk_fp8_f32(c[6], c[7], hi, true);
    u32x2 w; w.x = (unsigned)lo; w.y = (unsigned)hi; return w;
}
__device__ __forceinline__ void unpack8(u32x4 w, float (&v)[8]) { v[0] = bf_lo(w.x); v[1] = bf_hi(w.x); v[2] = bf_lo(w.y); v[3] = bf_hi(w.y); v[4] = bf_lo(w.z); v[5] = bf_hi(w.z); v[6] = bf_lo(w.w); v[7] = bf_hi(w.w); }

struct FIn {
    static constexpr int SEGS = 1; static constexpr bool PAIRED = true; typedef pg8::NoPre Pre;
    __device__ __forceinline__ void preload(int, int, Pre&) const {} __device__ __forceinline__ void preload_seam(int, int, Pre&) const {} __device__ __forceinline__ void seam(int, int, float (&)[8], const Pre&) const {}
    template <class TP> __device__ __forceinline__ void operator()(int, int, int, float (&)[8], const Pre&, const TP&, int) const {}
    bf16_t *Q, *KV, *PZ, *RG, *SGP; const float* bias; const float* SW; const float* XS0;
    static constexpr bool IACC = true;
    struct TilePre { u32x4 b[2]; f32x4 c[4]; };
    __device__ __forceinline__ float row_scale(int row) const { return XS0[row]; }
    __device__ __forceinline__ void tile_preload(int row0, int col, int pn, TilePre& t) const {
        const float* p0 = (pn < 7) ? bias + col : bias + 1792 + (pn - 7) * 128 + (col & 127);
        const float* p1 = (pn < 7) ? bias + col + 128 : bias + 2816 + (pn - 7) * 128 + (col & 127);
        { const f32x4 a0 = *(const f32x4*)p0, a1 = *(const f32x4*)(p0 + 4), a2 = *(const f32x4*)p1, a3 = *(const f32x4*)(p1 + 4);
          t.b[0].x = cvtpk(a0[0], a0[1]); t.b[0].y = cvtpk(a0[2], a0[3]); t.b[0].z = cvtpk(a1[0], a1[1]); t.b[0].w = cvtpk(a1[2], a1[3]);
          t.b[1].x = cvtpk(a2[0], a2[1]); t.b[1].y = cvtpk(a2[2], a2[3]); t.b[1].z = cvtpk(a3[0], a3[1]); t.b[1].w = cvtpk(a3[2], a3[3]); }
        t.c[0] = *(const f32x4*)(SW + col); t.c[1] = *(const f32x4*)(SW + col + 4); t.c[2] = *(const f32x4*)(SW + col + 128); t.c[3] = *(const f32x4*)(SW + col + 132);
    }
    __device__ __forceinline__ void plain(int row, int col, int pn, float (&v)[8], const u32x4& bb, const f32x4& c0, const f32x4& c1) const {
        float b[8]; unpack8(bb, b);
        v[0] = v[0] * c0[0] + b[0]; v[1] = v[1] * c0[1] + b[1]; v[2] = v[2] * c0[2] + b[2]; v[3] = v[3] * c0[3] + b[3]; v[4] = v[4] * c1[0] + b[4]; v[5] = v[5] * c1[1] + b[5]; v[6] = v[6] * c1[2] + b[6]; v[7] = v[7] * c1[3] + b[7];
        bf16_t* dst;
        if (pn < 4) { dst = Q + (size_t)row * 1024 + col;
#pragma unroll
            for (int i = 0; i < 8; ++i) v[i] *= QSCALE; }
        else if (pn == 4) dst = KV + (size_t)row * 256 + (col - 1024);
        else dst = PZ + (size_t)row * 512 + (col - 1280);
        *(u32x4*)dst = pack8(v);
    }
    __device__ __forceinline__ void pair(int row, int col, int pn, float (&v0)[8], float (&v1)[8], const TilePre& t) const {
        if (pn < 7) { plain(row, col, pn, v0, t.b[0], t.c[0], t.c[1]); plain(row, col + 128, pn, v1, t.b[1], t.c[2], t.c[3]); return; }
        const int ch = (pn - 7) * 128 + (col & 127);
        float ba[8], bp[8]; unpack8(t.b[0], ba); unpack8(t.b[1], bp);
        const float ca[8] = {t.c[0][0], t.c[0][1], t.c[0][2], t.c[0][3], t.c[1][0], t.c[1][1], t.c[1][2], t.c[1][3]}, cp[8] = {t.c[2][0], t.c[2][1], t.c[2][2], t.c[2][3], t.c[3][0], t.c[3][1], t.c[3][2], t.c[3][3]};
        float rr[8], sp[8];
#pragma unroll
        for (int i = 0; i < 8; ++i) { const float ep = fminf(1.f + __builtin_amdgcn_exp2f(-(v1[i] * cp[i] + bp[i]) * LOG2E), 1e30f);
            sp[i] = __builtin_amdgcn_rcpf(ep); rr[i] = sigmoidf_(v0[i] * ca[i] + ba[i]) * ep; }
        *(u32x4*)(RG + (size_t)row * 1024 + ch) = pack8(rr); *(u32x4*)(SGP + (size_t)row * 1024 + ch) = pack8(sp);
    }
};
struct FMerge {
    static constexpr int SEGS = 2; static constexpr bool PAIRED = false; template <class TP> __device__ __forceinline__ void pair(int, int, int, float (&)[8], float (&)[8], const TP&) const {} struct TilePre {}; static constexpr bool IACC = false; __device__ __forceinline__ void tile_preload(int, int, int, TilePre&) const {} __device__ __forceinline__ float row_scale(int) const { return 1.f; }
    struct Pre { u32x4 a; };
    const bf16_t* RG; const bf16_t* SGP; bf16_t* OUT;
    __device__ __forceinline__ void preload_seam(int row, int col, Pre& p) const { p.a = *(const u32x4*)(RG + (size_t)row * 1024 + col); }
    __device__ __forceinline__ void preload(int row, int col, Pre& p) const { p.a = *(const u32x4*)(SGP + (size_t)row * 1024 + col); }
    __device__ __forceinline__ void seam(int, int, float (&v)[8], const Pre& p) const {
        float a[8]; unpack8(p.a, a);
#pragma unroll
        for (int i = 0; i < 8; ++i) v[i] *= a[i];
    }
    __device__ __forceinline__ void operator()(int row, int col, int, float (&v)[8], const Pre& p, const TilePre&, int) const {
        float b[8]; unpack8(p.a, b);
#pragma unroll
        for (int i = 0; i < 8; ++i) v[i] *= b[i];
        *(u32x2*)((unsigned char*)OUT + (size_t)row * 1024 + col) = pack8_fp8(v, MRG_SCALE);
    }
};
struct FRes {
    static constexpr int SEGS = 1; static constexpr bool PAIRED = false; template <class TP> __device__ __forceinline__ void pair(int, int, int, float (&)[8], float (&)[8], const TP&) const {} struct TilePre {}; static constexpr bool IACC = false; __device__ __forceinline__ void tile_preload(int, int, int, TilePre&) const {} __device__ __forceinline__ float row_scale(int) const { return 1.f; }
    struct Pre { u32x4 a; float r; };
    const bf16_t* XH; const float* IRS; bf16_t* H;
    __device__ __forceinline__ void preload(int row, int col, Pre& p) const { p.a = *(const u32x4*)(XH + (size_t)row * 1024 + col); p.r = IRS[row]; }
    __device__ __forceinline__ void preload_seam(int, int, Pre&) const {}
    __device__ __forceinline__ void seam(int, int, float (&)[8], const Pre&) const {}
    __device__ __forceinline__ void operator()(int row, int col, int, float (&v)[8], const Pre& p, const TilePre&, int) const {
        float xh[8]; unpack8(p.a, xh);
#pragma unroll
        for (int i = 0; i < 8; ++i) v[i] = v[i] * (1.f / (MRG_SCALE * W8_SCALE)) + xh[i] * p.r;
        *(u32x4*)(H + (size_t)row * 1024 + col) = pack8(v);
    }
};
struct FQP {
    static constexpr int SEGS = 1; static constexpr bool PAIRED = false; template <class TP> __device__ __forceinline__ void pair(int, int, int, float (&)[8], float (&)[8], const TP&) const {}
    static constexpr bool IACC = true;
    typedef pg8::NoPre Pre;
    unsigned short* OUT; const float* XS; const float* SW;
    struct TilePre { f32x4 c[4]; };
    __device__ __forceinline__ void tile_preload(int, int col, int, TilePre& t) const { t.c[0] = *(const f32x4*)(SW + col); t.c[1] = *(const f32x4*)(SW + col + 4); t.c[2] = *(const f32x4*)(SW + col + 128); t.c[3] = *(const f32x4*)(SW + col + 132); }
    __device__ __forceinline__ float row_scale(int row) const { return XS[row]; }
    __device__ __forceinline__ void preload(int, int, Pre&) const {}
    __device__ __forceinline__ void preload_seam(int, int, Pre&) const {}
    __device__ __forceinline__ void seam(int, int, float (&)[8], const Pre&) const {}
    __device__ __forceinline__ void operator()(int row, int col, int, float (&v)[8], const Pre&, const TilePre& t, int bj) const {
        const int hp = col >> 7, key0 = col & 127, hh = key0 >> 6, c = (key0 & 63) >> 3;
        const f32x4 c0 = bj ? t.c[2] : t.c[0], c1 = bj ? t.c[3] : t.c[1];
        typedef _Float16 h2_t __attribute__((ext_vector_type(2)));
        u32x4 w;
        { const h2_t a = __builtin_convertvector((f32x2_t){v[0] * c0[0], v[1] * c0[1]}, h2_t), b = __builtin_convertvector((f32x2_t){v[2] * c0[2], v[3] * c0[3]}, h2_t), cc = __builtin_convertvector((f32x2_t){v[4] * c1[0], v[5] * c1[1]}, h2_t), d = __builtin_convertvector((f32x2_t){v[6] * c1[2], v[7] * c1[3]}, h2_t);
          w.x = __builtin_bit_cast(unsigned, a); w.y = __builtin_bit_cast(unsigned, b); w.z = __builtin_bit_cast(unsigned, cc); w.w = __builtin_bit_cast(unsigned, d); }
        *(u32x4*)(OUT + ((size_t)((row >> 5) * 16 + hp) * 4096 + (((c * 2 + hh) * 32 + (row & 31)) * 8))) = w;
    }
};
struct FPlain {
    static constexpr int SEGS = 1; static constexpr bool PAIRED = false; template <class TP> __device__ __forceinline__ void pair(int, int, int, float (&)[8], float (&)[8], const TP&) const {} typedef pg8::NoPre Pre; __device__ __forceinline__ void preload(int, int, Pre&) const {} __device__ __forceinline__ void preload_seam(int, int, Pre&) const {} __device__ __forceinline__ void seam(int, int, float (&)[8], const Pre&) const {} struct TilePre {}; static constexpr bool IACC = false; __device__ __forceinline__ void tile_preload(int, int, int, TilePre&) const {} __device__ __forceinline__ float row_scale(int) const { return 1.f; }
    bf16_t* OUT; int ldc;
    __device__ __forceinline__ void operator()(int row, int col, int, float (&v)[8], const Pre&, const TilePre&, int) const { *(u32x4*)(OUT + (size_t)row * ldc + col) = pack8(v); }
};

__device__ __forceinline__ int gate_src_col(int n) { if (n < 1792) return n; const int o = n - 1792, t = o >> 8, h = (o >> 7) & 1, i = o & 127; return (h ? 2816 : 1792) + 128 * t + i; }
__device__ __forceinline__ void p0_transpose_item(const float* W, int K, int N, bf16_t* WT, LAS float* scr, int item, int lane, int ldk = 0, const float* kgain = nullptr, bool nperm = false, float f8scale = 0.f) {
    if (ldk == 0) ldk = K;
    const int nblk = N / 32, kb = item / nblk, nb = item % nblk, k0 = 64 * kb, n0 = 32 * nb, ns = nperm ? gate_src_col(n0) : n0;
#pragma unroll 8
    for (int i = 0; i < 32; ++i) { const int kk = 2 * i + (lane >> 5); scr[kk * 33 + (lane & 31)] = W[(size_t)(k0 + kk) * N + ns + (lane & 31)] * (kgain ? kgain[k0 + kk] : 1.f); }
    asm volatile("s_waitcnt lgkmcnt(0)" ::: "memory");
    const int c = lane & 7;
#pragma unroll
    for (int j = 0; j < 4; ++j) { const int n = (lane >> 3) + 8 * j; const LAS float* s = scr + (8 * c) * 33 + n;
        if (f8scale != 0.f) { const float v8[8] = {s[0 * 33], s[1 * 33], s[2 * 33], s[3 * 33], s[4 * 33], s[5 * 33], s[6 * 33], s[7 * 33]};
            *(u32x2*)((unsigned char*)WT + (size_t)(n0 + n) * ldk + k0 + 8 * c) = pack8_fp8(v8, f8scale); continue; }
        u32x4 o; o.x = cvtpk(s[0 * 33], s[1 * 33]); o.y = cvtpk(s[2 * 33], s[3 * 33]); o.z = cvtpk(s[4 * 33], s[5 * 33]); o.w = cvtpk(s[6 * 33], s[7 * 33]);
        *(u32x4*)(WT + (size_t)(n0 + n) * ldk + k0 + 8 * c) = o; }
    asm volatile("s_waitcnt lgkmcnt(0)" ::: "memory");
}
template <int R, class SRC> __device__ __forceinline__ void rms_rows_to_bf16(const SRC* xrow, size_t rstride, const float* gain, bf16_t* orow, int lane, signed char* x8 = nullptr, float* xs = nullptr, size_t sstride = 0, float* irs = nullptr) {
    f32x4 v[R][4];
#pragma unroll
    for (int r = 0; r < R; ++r)
#pragma unroll
        for (int j = 0; j < 4; ++j) {
            if constexpr (sizeof(SRC) == 4) v[r][j] = *((const f32x4*)(xrow + r * rstride) + lane + 64 * j);
            else { const u32x2 w = *((const u32x2*)(xrow + r * rstride) + lane + 64 * j); v[r][j] = (f32x4){bf_lo(w.x), bf_hi(w.x), bf_lo(w.y), bf_hi(w.y)}; } }
    f32x4 gg[4];
#pragma unroll
    for (int j = 0; j < 4; ++j) gg[j] = gain ? *((const f32x4*)gain + lane + 64 * j) : (f32x4){1.f, 1.f, 1.f, 1.f};
#pragma unroll
    for (int r = 0; r < R; ++r) {
        float s = 0.f;
#pragma unroll
        for (int j = 0; j < 4; ++j) s += (v[r][j].x * v[r][j].x + v[r][j].y * v[r][j].y) + (v[r][j].z * v[r][j].z + v[r][j].w * v[r][j].w);
        const float rms = sqrtf(wave_sum(s) * (1.f / D) + EPS), rstd = 1.f / rms;
        if (irs && lane == 0) irs[r * sstride] = orow ? rms : rstd;
        u32x2* o8 = (u32x2*)(orow + r * rstride) + lane;
        float m = 0.f;
#pragma unroll
        for (int j = 0; j < 4; ++j) { v[r][j] = (f32x4){v[r][j].x * rstd * gg[j].x, v[r][j].y * rstd * gg[j].y, v[r][j].z * rstd * gg[j].z, v[r][j].w * rstd * gg[j].w};
            if (orow) { u32x2 w; w.x = cvtpk(v[r][j].x, v[r][j].y); w.y = cvtpk(v[r][j].z, v[r][j].w); o8[64 * j] = w; }
            m = fmaxf(fmaxf(m, fmaxf(fabsf(v[r][j].x), fabsf(v[r][j].y))), fmaxf(fabsf(v[r][j].z), fabsf(v[r][j].w))); }
        if (x8) {
#pragma unroll
            for (int o = 1; o < 64; o <<= 1) m = fmaxf(m, __shfl_xor(m, o));
            const float sc = m > 0.f ? 127.f / m : 1.f;
#pragma unroll
            for (int j = 0; j < 4; ++j) { const int q0 = __float2int_rn(v[r][j].x * sc), q1 = __float2int_rn(v[r][j].y * sc), q2 = __float2int_rn(v[r][j].z * sc), q3 = __float2int_rn(v[r][j].w * sc);
                *((unsigned*)(x8 + r * rstride) + lane + 64 * j) = (unsigned)((q0 & 0xff) | ((q1 & 0xff) << 8) | ((q2 & 0xff) << 16) | (q3 << 24)); }
            if (lane == 0) xs[r * sstride] = m > 0.f ? m / 127.f : 1.f;
        }
    }
}
__device__ __forceinline__ void quant_row_i8(const bf16_t* wrow, signed char* orow, float* sc_out, int lane) {
    const u32x4 wa = ((const u32x4*)wrow)[lane], wb = ((const u32x4*)wrow)[64 + lane];
    float va[8], vb[8]; unpack8(wa, va); unpack8(wb, vb);
    float m = 0.f;
#pragma unroll
    for (int i = 0; i < 8; ++i) m = fmaxf(m, fmaxf(fabsf(va[i]), fabsf(vb[i])));
#pragma unroll
    for (int o = 1; o < 64; o <<= 1) m = fmaxf(m, __shfl_xor(m, o));
    const float sc = m > 0.f ? 127.f / m : 0.f;
    int qa[8], qb[8];
#pragma unroll
    for (int i = 0; i < 8; ++i) { qa[i] = __float2int_rn(va[i] * sc) & 0xff; qb[i] = __float2int_rn(vb[i] * sc) & 0xff; }
    u32x2 oa, ob; oa.x = qa[0] | (qa[1] << 8) | (qa[2] << 16) | (qa[3] << 24); oa.y = qa[4] | (qa[5] << 8) | (qa[6] << 16) | (qa[7] << 24);
    ob.x = qb[0] | (qb[1] << 8) | (qb[2] << 16) | (qb[3] << 24); ob.y = qb[4] | (qb[5] << 8) | (qb[6] << 16) | (qb[7] << 24);
    *(u32x2*)(orow + lane * 8) = oa; *(u32x2*)(orow + 512 + lane * 8) = ob;
    if (lane == 0) *sc_out = m * (1.f / 127.f);
}
template <int R, bool I8> __device__ __forceinline__ void fp8_rows(const float* const (&src)[R], unsigned char* const (&dst)[R], float* const (&inv)[R], int lane) {
    f32x4 v[R][4];
#pragma unroll
    for (int r = 0; r < R; ++r)
#pragma unroll
        for (int j = 0; j < 4; ++j) v[r][j] = *((const f32x4*)src[r] + lane + 64 * j);
#pragma unroll
    for (int r = 0; r < R; ++r) {
        float m = 0.f;
#pragma unroll
        for (int j = 0; j < 4; ++j) m = fmaxf(fmaxf(m, fmaxf(fabsf(v[r][j].x), fabsf(v[r][j].y))), fmaxf(fabsf(v[r][j].z), fabsf(v[r][j].w)));
#pragma unroll
        for (int o = 1; o < 64; o <<= 1) m = fmaxf(m, __shfl_xor(m, o));
        const float qmax = I8 ? 127.f : 448.f;
        const float sc = m > 0.f ? qmax / m : 1.f;
#pragma unroll
        for (int j = 0; j < 4; ++j) { int w = 0;
            if (I8) { const int q0 = __float2int_rn(v[r][j].x * sc), q1 = __float2int_rn(v[r][j].y * sc), q2 = __float2int_rn(v[r][j].z * sc), q3 = __float2int_rn(v[r][j].w * sc);
                w = (q0 & 0xff) | ((q1 & 0xff) << 8) | ((q2 & 0xff) << 16) | (q3 << 24); }
            else { w = __builtin_amdgcn_cvt_pk_fp8_f32(v[r][j].x * sc, v[r][j].y * sc, w, false); w = __builtin_amdgcn_cvt_pk_fp8_f32(v[r][j].z * sc, v[r][j].w * sc, w, true); }
            *((unsigned*)(dst[r] + (size_t)(2 * j + (lane >> 5)) * (NEXP * 128)) + (lane & 31)) = (unsigned)w; }
        if (lane == 0) *inv[r] = m > 0.f ? m / qmax : 1.f;
    }
}
__device__ __forceinline__ float reduce16(float (&v)[16], int lane) {
#pragma unroll
    for (int i = 0; i < 8; ++i) { const bool up = (lane & 32) != 0; const float send = up ? v[i] : v[i + 8], keep = up ? v[i + 8] : v[i]; v[i] = keep + __shfl_xor(send, 32); }
#pragma unroll
    for (int i = 0; i < 4; ++i) { const bool up = (lane & 16) != 0; const float send = up ? v[i] : v[i + 4], keep = up ? v[i + 4] : v[i]; v[i] = keep + __shfl_xor(send, 16); }
#pragma unroll
    for (int i = 0; i < 2; ++i) { const bool up = (lane & 8) != 0; const float send = up ? v[i] : v[i + 2], keep = up ? v[i + 2] : v[i]; v[i] = keep + __shfl_xor(send, 8); }
    { const bool up = (lane & 4) != 0; const float send = up ? v[0] : v[1], keep = up ? v[1] : v[0]; v[0] = keep + __shfl_xor(send, 4); }
    float r = v[0]; r += __shfl_xor(r, 2); r += __shfl_xor(r, 1); return r;
}

namespace att {
constexpr int KSTR = 144, VSTR = 392, NSLOT = 6, K_OFF = 0, V_OFF = NSLOT * 32 * KSTR;
__device__ __forceinline__ int crow(int r, int hi) { return (r & 3) + 8 * (r >> 2) + 4 * hi; }
__device__ __forceinline__ void run(LAS unsigned char* lds, const bf16_t* Q, const bf16_t* KV, bf16_t* O, int ostride, const float* sinks, int b, int kvh, int rn) {
    const int tid = threadIdx.x, lane = tid & 63, wid = __builtin_amdgcn_readfirstlane(tid >> 6);
    const int r0 = rn * 512; const long rowbase = (long)b * SEQ;
    const int q = lane & 31, hi = lane >> 5, hq = kvh * 8 + wid;
    const int kfirst = (r0 == 0) ? 4 : 0;
    const int sx = tid & 255, skey = sx >> 3, spart = sx & 7; const bool isv = tid >= 256;
    const bf16_t* sbase = KV + (rowbase + r0 - 128 + skey) * 256 + (isv ? 128 : 0) + kvh * 64 + spart * 8;
#define ATT_WRITE(val, slot) do { if (!isv) *(LAS u32x4*)(lds + K_OFF + ((slot) * 32 + skey) * KSTR + spart * 16) = (val); else { \
        LAS unsigned short* vt_ = (LAS unsigned short*)(lds + V_OFF + (spart * 8) * VSTR + ((slot) * 32 + skey) * 2); \
        vt_[0 * (VSTR / 2)] = (unsigned short)((val).x & 0xffffu); vt_[1 * (VSTR / 2)] = (unsigned short)((val).x >> 16); vt_[2 * (VSTR / 2)] = (unsigned short)((val).y & 0xffffu); vt_[3 * (VSTR / 2)] = (unsigned short)((val).y >> 16); \
        vt_[4 * (VSTR / 2)] = (unsigned short)((val).z & 0xffffu); vt_[5 * (VSTR / 2)] = (unsigned short)((val).z >> 16); vt_[6 * (VSTR / 2)] = (unsigned short)((val).w & 0xffffu); vt_[7 * (VSTR / 2)] = (unsigned short)((val).w >> 16); } } while (0)
    { u32x4 pv[5];
#pragma unroll
      for (int k = 0; k < 5; ++k) pv[k] = *(const u32x4*)(sbase + (size_t)(k >= kfirst ? k : 4) * 32 * 256);
#pragma unroll
      for (int k = 0; k < 5; ++k) if (k >= kfirst) ATT_WRITE(pv[k], k); }
    const float sink2 = sinks[hq] * LOG2E;
    bf16x8 qf[4];
#pragma unroll
    for (int s = 0; s < 4; ++s) qf[s] = *(const bf16x8*)(Q + (rowbase + r0 + q) * 1024 + hq * 64 + s * 16 + hi * 8);
    __syncthreads();
    for (int i = 0; i < 16; ++i) {
        const int q0 = r0 + i * 32;
        const int jstart = (kfirst > i) ? kfirst - i : 0;
        u32x4 stg = (u32x4){0u, 0u, 0u, 0u};
        if (i < 15) stg = *(const u32x4*)(sbase + (size_t)(i + 5) * 32 * 256);
        bf16x8 qn[4];
        { const int inx = (i < 15) ? i + 1 : i;
#pragma unroll
          for (int s = 0; s < 4; ++s) qn[s] = *(const bf16x8*)(Q + (rowbase + r0 + inx * 32 + q) * 1024 + hq * 64 + s * 16 + hi * 8); }
        f32x16 p[5];
#pragma unroll
        for (int j = 0; j < 5; ++j) {
            p[j] = (f32x16){0.f, 0.f, 0.f, 0.f, 0.f, 0.f, 0.f, 0.f, 0.f, 0.f, 0.f, 0.f, 0.f, 0.f, 0.f, 0.f};
            if (j >= jstart) { const int slot = (i + j) % NSLOT;
#pragma unroll
                for (int s = 0; s < 4; ++s) { const bf16x8 kf = *(const LAS bf16x8*)(lds + K_OFF + (slot * 32 + q) * KSTR + (16 * s + 8 * hi) * 2);
                    p[j] = __builtin_amdgcn_mfma_f32_32x32x16_bf16(kf, qf[s], p[j], 0, 0, 0); }
            }
        }
        const float NEG = -1e30f;
        float mx = sink2;
#pragma unroll
        for (int j = 0; j < 5; ++j)
#pragma unroll
            for (int r = 0; r < 16; ++r) { const int cr = crow(r, hi);
                const bool ok = (j >= jstart) && ((j == 0) ? (q < cr) : (j == 4) ? (cr <= q) : true);
                const float sv = ok ? p[j][r] : NEG; p[j][r] = sv; mx = fmaxf(mx, sv); }
        mx = fmaxf(mx, __shfl_xor(mx, 32));
        float l = 0.f;
#pragma unroll
        for (int j = 0; j < 5; ++j)
#pragma unroll
            for (int r = 0; r < 16; ++r) { const float e = __builtin_amdgcn_exp2f(p[j][r] - mx); p[j][r] = e; l += e; }
        l += __shfl_xor(l, 32); l += __builtin_amdgcn_exp2f(sink2 - mx);
        f32x16 o[2];
        o[0] = (f32x16){0.f, 0.f, 0.f, 0.f, 0.f, 0.f, 0.f, 0.f, 0.f, 0.f, 0.f, 0.f, 0.f, 0.f, 0.f, 0.f}; o[1] = o[0];
#pragma unroll
        for (int j = 0; j < 5; ++j) {
            if (j >= jstart) { const int slot = (i + j) % NSLOT;
#pragma unroll
                for (int s2 = 0; s2 < 2; ++s2) {
                    u32x4 pw; pw.x = cvtpk(p[j][8 * s2 + 0], p[j][8 * s2 + 1]); pw.y = cvtpk(p[j][8 * s2 + 2], p[j][8 * s2 + 3]); pw.z = cvtpk(p[j][8 * s2 + 4], p[j][8 * s2 + 5]); pw.w = cvtpk(p[j][8 * s2 + 6], p[j][8 * s2 + 7]);
                    const bf16x8 pf = __builtin_bit_cast(bf16x8, pw);
#pragma unroll
                    for (int db = 0; db < 2; ++db) {
                        const LAS unsigned char* vp = lds + V_OFF + (32 * db + q) * VSTR + (slot * 32 + 16 * s2 + 4 * hi) * 2;
                        const u32x2 lo = *(const LAS u32x2*)vp, hh = *(const LAS u32x2*)(vp + 16);
                        u32x4 vw; vw.x = lo.x; vw.y = lo.y; vw.z = hh.x; vw.w = hh.y;
                        o[db] = __builtin_amdgcn_mfma_f32_32x32x16_bf16(__builtin_bit_cast(bf16x8, vw), pf, o[db], 0, 0, 0);
                    }
                }
            }
        }
        const float inv = 1.f / l;
        bf16_t* orow = O + (rowbase + q0 + q) * ostride + hq * 64;
#pragma unroll
        for (int db = 0; db < 2; ++db)
#pragma unroll
            for (int g4 = 0; g4 < 4; ++g4) { u32x2 w; w.x = cvtpk(o[db][4 * g4] * inv, o[db][4 * g4 + 1] * inv); w.y = cvtpk(o[db][4 * g4 + 2] * inv, o[db][4 * g4 + 3] * inv);
                *(u32x2*)(orow + 32 * db + 8 * g4 + 4 * hi) = w; }
        if (i < 15) { const int slot = (i + 5) % NSLOT; ATT_WRITE(stg, slot); }
#pragma unroll
        for (int s = 0; s < 4; ++s) qf[s] = qn[s];
        __syncthreads();
    }
#undef ATT_WRITE
}
}

__device__ __forceinline__ float gelu_erf(float v) {
    const float av = fabsf(v), t = __builtin_amdgcn_rcpf(av * 0.2316418882f + 1.0f);
    float q = t * 0.5307027145f + (-0.7265760135f); q = q * t + 0.7107068705f; q = q * t + (-0.142248368f); q = q * t + 0.127414796f; q = q * t;
    const float e = __builtin_amdgcn_exp2f((v * v) * (-0.72134752044f));
    const float m = v * (q * e);
    return v < 0.f ? m : v - m;
}

namespace tk {
__device__ __forceinline__ void ce(unsigned& a, unsigned& b) { const unsigned mx = a > b ? a : b, mn = a > b ? b : a; a = mx; b = mn; }
__device__ __forceinline__ void sort16(unsigned (&v)[16]) {
    constexpr int NET[60][2] = {{0,13},{1,12},{2,15},{3,14},{4,8},{5,6},{7,11},{9,10}, {0,5},{1,7},{2,9},{3,4},{6,13},{8,14},{10,15},{11,12}, {0,1},{2,3},{4,5},{6,8},{7,9},{10,11},{12,13},{14,15},
        {0,2},{1,3},{4,10},{5,11},{6,7},{8,9},{12,14},{13,15}, {1,2},{3,12},{4,6},{5,7},{8,10},{9,11},{13,14}, {1,4},{2,6},{5,8},{7,10},{9,13},{11,14}, {2,4},{3,6},{9,12},{11,13}, {3,5},{6,8},{7,9},{10,12},
        {3,4},{5,6},{7,8},{9,10},{11,12}, {6,7},{8,9}};
#pragma unroll
    for (int i = 0; i < 60; ++i) ce(v[NET[i][0]], v[NET[i][1]]);
}
__device__ __forceinline__ void merge16(unsigned (&r)[16], const unsigned (&n)[16]) {
#pragma unroll
    for (int i = 0; i < 16; ++i) r[i] = r[i] > n[15 - i] ? r[i] : n[15 - i];
#pragma unroll
    for (int j = 8; j > 0; j >>= 1)
#pragma unroll
        for (int i = 0; i < 16; ++i) if ((i & j) == 0) ce(r[i], r[i + j]);
}
__device__ __forceinline__ void merge16_xlane(unsigned (&r)[16]) {
    unsigned n[16];
#pragma unroll
    for (int i = 0; i < 16; ++i) n[i] = (unsigned)__shfl_xor((int)r[i], 32);
    merge16(r, n);
}
typedef short s16x2_t __attribute__((ext_vector_type(2)));
__device__ __forceinline__ unsigned okey16x2(unsigned w) { const s16x2_t sg = __builtin_bit_cast(s16x2_t, w) >> 15; return w ^ (__builtin_bit_cast(unsigned, sg) | 0x80008000u); }
__device__ __forceinline__ float ofloat16(unsigned k) { const unsigned x = k >> 16; const unsigned h = (x & 0x8000u) ? (x ^ 0x8000u) : (~x & 0xffffu); return (float)__builtin_bit_cast(_Float16, (unsigned short)h); }
__device__ __forceinline__ unsigned okey(float f) { const unsigned u = __float_as_uint(f); return u ^ ((unsigned)((int)u >> 31) | 0x80000000u); }
__device__ __forceinline__ float ofloat(unsigned k) { return __uint_as_float(k ^ (~(unsigned)((int)k >> 31) | 0x80000000u)); }
}

#define XB_TMO      128
#define XB_XCNT(j)  (256  + 64 * (j))
#define XB_XSUB(j)  (1280 + 64 * (j))
#define XB_XGEN(j)  (2304 + 64 * (j))
#define XB_TOP      3328
#define XB_TOPGEN   3392
#define XCD_BAR_WORDS 3456
#define XB_SPIN_CAP (1u << 18)
__device__ __forceinline__ unsigned xb_ld(unsigned* p)              { return __hip_atomic_load(p, __ATOMIC_RELAXED, __HIP_MEMORY_SCOPE_AGENT); }
__device__ __forceinline__ unsigned xb_add(unsigned* p, unsigned v) { return __hip_atomic_fetch_add(p, v, __ATOMIC_RELAXED, __HIP_MEMORY_SCOPE_AGENT); }
__device__ __forceinline__ unsigned xb_xcc_id() { return (unsigned)__builtin_amdgcn_s_getreg((3 << 11) | 20) & 0xFu; }
#define XB_SPIN(cond, bar) do { unsigned _sp = 0; while (cond) { __builtin_amdgcn_s_sleep(1); \
    if ((++_sp & 255u) == 0u) { if (xb_ld(&(bar)[XB_TMO])) break; if (_sp > XB_SPIN_CAP) { atomicAdd(&(bar)[XB_TMO], 1u); break; } } } } while (0)
struct XcdBarrier { unsigned* bar; unsigned x; volatile LAS unsigned* st; };
__device__ __forceinline__ XcdBarrier xcd_barrier_post(unsigned* bar, volatile LAS unsigned* st) {
    XcdBarrier b; b.bar = bar; b.x = xb_xcc_id(); b.st = st;
    if (threadIdx.x == 0) (void)xb_add(&bar[XB_XCNT(b.x)], 1u);
    return b;
}
__device__ __forceinline__ void xcd_barrier_complete(unsigned* bar, unsigned x, unsigned& nloc, unsigned& nx) {
    const unsigned G = gridDim.x * gridDim.y * gridDim.z;
    unsigned sum, cnt, mine, sp = 0u;
    for (;;) {
        sum = 0u; cnt = 0u; mine = 0u;
#pragma unroll
        for (unsigned j = 0; j < 16; ++j) { const unsigned c = xb_ld(&bar[XB_XCNT(j)]); sum += c; cnt += (c > 0u) ? 1u : 0u; mine = (j == x) ? c : mine; }
        if (sum == G) break;
        __builtin_amdgcn_s_sleep(1);
        if ((++sp & 255u) == 0u) { if (xb_ld(&bar[XB_TMO])) break; if (sp > XB_SPIN_CAP) { atomicAdd(&bar[XB_TMO], 1u); break; } }
    }
    nloc = mine > 0u ? mine : 1u; nx = cnt > 0u ? cnt : 1u;
}
__device__ __forceinline__ void xcd_barrier(const XcdBarrier& b) {
    asm volatile("s_waitcnt vmcnt(0)" ::: "memory");
    __syncthreads();
    if (threadIdx.x == 0) {
        unsigned* bar = b.bar;
        __builtin_amdgcn_s_waitcnt(0);
        unsigned nloc = b.st[0], nx = b.st[1];
        if (nloc == 0u) { xcd_barrier_complete(bar, b.x, nloc, nx); b.st[0] = nloc; b.st[1] = nx; }
        const unsigned old = xb_add(&bar[XB_XSUB(b.x)], 1u);
        const unsigned gen = old / nloc;
        if (old + 1u == (gen + 1u) * nloc) {
            __builtin_amdgcn_fence(__ATOMIC_RELEASE, "agent");
            asm volatile("s_waitcnt vmcnt(0)" ::: "memory");
            const unsigned og = xb_add(&bar[XB_TOP], 1u);
            const unsigned tg = og / nx;
            if (og + 1u == (tg + 1u) * nx) xb_add(&bar[XB_TOPGEN], 1u);
            else XB_SPIN(xb_ld(&bar[XB_TOPGEN]) == tg, bar);
            __builtin_amdgcn_fence(__ATOMIC_ACQUIRE, "agent");
            xb_add(&bar[XB_XGEN(b.x)], 1u);
            asm volatile("s_waitcnt vmcnt(0)" ::: "memory");
        } else {
            XB_SPIN(xb_ld(&bar[XB_XGEN(b.x)]) == gen, bar);
            __builtin_amdgcn_fence(__ATOMIC_ACQUIRE, "agent");
            asm volatile("s_waitcnt vmcnt(0)" ::: "memory");
        }
    }
    __syncthreads();
}

#define PROBE_PHASE_A (-1)
#define PROBE_GEMM (-1)
#define PROBE_PHASE_B (-1)
#define PROBE_COUNT 1
#define USE_CG_SEAM0 0
#define PROBE_ATT 1
struct Args { const float* in[16]; float* out; unsigned char* ws; int ph_lo, ph_hi; };

__global__ void __launch_bounds__(512, 2) fwd(Args args) {
    extern __shared__ __attribute__((aligned(16))) unsigned char lds_raw[];
    LAS unsigned char* lds = (LAS unsigned char*)lds_raw;
    cg::grid_group grid = cg::this_grid();
    const int tid = threadIdx.x, lane = tid & 63, wave = __builtin_amdgcn_readfirstlane(tid >> 6);
    const int G = gridDim.x, bx = blockIdx.x;
    const int vcu = (G % 8 == 0) ? (bx % 8) * (G / 8) + bx / 8 : bx;
    const int gw = vcu * 8 + wave, NGW = G * 8;
    const int gt = vcu * 512 + tid, NGT = G * 512;
    unsigned char* ws = args.ws;
    const float* x = args.in[0]; const float* ln_mix_g = args.in[1]; const float* w_in = args.in[2]; const float* b_in = args.in[3];
    const float* sinks = args.in[4]; const float* w_attn_up = args.in[5]; const float* w_pool_grp = args.in[6]; const float* pool_scale = args.in[7];
    const float* w_pool_up = args.in[8]; const float* w_o = args.in[9]; const float* ln_ffn_g = args.in[10]; const float* w_query = args.in[11];
    const float* sub_keys = args.in[12]; const float* u_exp = args.in[13]; const float* v_exp = args.in[14]; const float* ln_final_g = args.in[15];
    float* out = args.out;
    bf16_t* WIN = (bf16_t*)(ws + WS_WIN); bf16_t* WUP = (bf16_t*)(ws + WS_WUP); bf16_t* WPU = (bf16_t*)(ws + WS_WPU); bf16_t* WO = (bf16_t*)(ws + WS_WO);
    bf16_t* WQC = (bf16_t*)(ws + WS_WQC); unsigned char* UT = ws + WS_U; unsigned char* VT = ws + WS_V;
    float* SCU = (float*)(ws + WS_SCU); float* SCV = (float*)(ws + WS_SCV); bf16_t* H = (bf16_t*)(ws + WS_H);
    bf16_t* XN = (bf16_t*)(ws + WS_XN); bf16_t* QB = (bf16_t*)(ws + WS_X8);   bf16_t* AOP = (bf16_t*)(ws + WS_Q);   bf16_t* KVB = (bf16_t*)(ws + WS_KV);
    bf16_t* PZ = (bf16_t*)(ws + WS_PZ); bf16_t* PL = (bf16_t*)(ws + WS_PL); bf16_t* SGA = (bf16_t*)(ws + WS_SGA); bf16_t* SGP = (bf16_t*)(ws + WS_SGP);
    bf16_t* MRG = QB;   float* IRS = (float*)(ws + WS_XS + 524288); float* RS2 = (float*)(ws + WS_XS + 1048576); bf16_t* QP = (bf16_t*)(ws + WS_Q); unsigned short* EID = (unsigned short*)(ws + WS_EID); bf16_t* GSM = (bf16_t*)(ws + WS_GSM); signed char* XH8 = (signed char*)(ws + WS_XH8); float* XS0 = (float*)(ws + WS_XS0); signed char* WQ8 = (signed char*)(ws + WS_WQ8); float* SWQ = (float*)(ws + WS_SWQ); signed char* WIN8 = (signed char*)(ws + WS_WIN8); float* SWIN = (float*)(ws + WS_SWIN); signed char* GS8 = (signed char*)(ws + WS_GS8); float* WSC = (float*)(ws + WS_WSC); unsigned short* PART = (unsigned short*)(ws + WS_Q);     signed char* X8 = (signed char*)(ws + WS_X8); float* XS = (float*)(ws + WS_XS); float* SS = (float*)(ws + WS_CTL + 262144); unsigned* CNT = (unsigned*)(ws + WS_CTL + 786432);
    const int lo = args.ph_lo, hi = args.ph_hi;
    volatile LAS unsigned* MISC = (volatile LAS unsigned*)(lds + 155648);
    if (tid < 4) MISC[tid] = 0u;
    __syncthreads();
    XcdBarrier xbar = xcd_barrier_post((unsigned*)(ws + WS_CTL), MISC);
#define IN(k) (lo <= (k) && (k) < hi)
#define GREP(k) (((k) == PROBE_GEMM) ? PROBE_COUNT : 1)
#define PH(k) for (int rep_ = 0; rep_ < (((k) == PROBE_PHASE_A || (k) == PROBE_PHASE_B) ? PROBE_COUNT : 1); ++rep_, (rep_ < (((k) == PROBE_PHASE_A || (k) == PROBE_PHASE_B) ? PROBE_COUNT : 1) ? grid.sync() : (void)0))
#define SEAM(k) do { if (IN(k) && IN((k) + 1)) { if (USE_CG_SEAM0 && (k) == 0) grid.sync(); else xcd_barrier(xbar); } } while (0)

    PH(0) if (IN(0)) {
        for (int step = 0; step < 2; ++step) {
            const bool prep = (step == 0) == (wave < 4);
            if (prep) {
                for (int wt = gw; wt < 2048; wt += NGW) {
                    const int hp = wt >> 7, mt = (wt >> 5) & 3, ntile = wt & 31, r32 = lane & 31, hi2 = lane >> 5;
                    const float* ap = sub_keys + (size_t)(hp * 128 + mt * 32 + r32) * 128 + hi2 * 8;
                    const float* bp = w_query + (size_t)(ntile * 32 + r32) * 2048 + hp * 128 + hi2 * 8;
                    const float g2k = 1.f;
                    f32x16 cacc = (f32x16){0.f, 0.f, 0.f, 0.f, 0.f, 0.f, 0.f, 0.f, 0.f, 0.f, 0.f, 0.f, 0.f, 0.f, 0.f, 0.f};
        #pragma unroll
                    for (int s2 = 0; s2 < 8; ++s2) {
                        const f32x4 a0 = *(const f32x4*)(ap + s2 * 16), a1 = *(const f32x4*)(ap + s2 * 16 + 4), b0 = *(const f32x4*)(bp + s2 * 16), b1 = *(const f32x4*)(bp + s2 * 16 + 4);
                        u32x4 aw, bw; aw.x = cvtpk(a0.x, a0.y); aw.y = cvtpk(a0.z, a0.w); aw.z = cvtpk(a1.x, a1.y); aw.w = cvtpk(a1.z, a1.w);
                        bw.x = cvtpk(b0.x * g2k, b0.y * g2k); bw.y = cvtpk(b0.z * g2k, b0.w * g2k); bw.z = cvtpk(b1.x * g2k, b1.y * g2k); bw.w = cvtpk(b1.z * g2k, b1.w * g2k);
                        cacc = __builtin_amdgcn_mfma_f32_32x32x16_bf16(__builtin_bit_cast(bf16x8, aw), __builtin_bit_cast(bf16x8, bw), cacc, 0, 0, 0);
                    }
        #pragma unroll
                    for (int r = 0; r < 16; ++r) WQC[(size_t)(hp * 128 + mt * 32 + att::crow(r, hi2)) * 1024 + ntile * 32 + r32] = (bf16_t)(cvtpk(cacc[r], 0.f) & 0xffffu);
                }
                LAS float* scr = (LAS float*)(lds + wave * 16384);
                constexpr int I_IN = 16 * (INW / 32), I_SQ = 16 * 32;
                for (int it = gw; it < I_IN + 2 * I_SQ; it += NGW) {
                    int r = it;
                    if (r < I_IN) { p0_transpose_item(w_in, 1024, INW, WIN, scr, r, lane, 0, ln_mix_g, true);   continue; } r -= I_IN;
                    if (r < I_SQ) { p0_transpose_item(w_attn_up, 1024, 1024, WUP, scr, r, lane, 1536);   continue; } r -= I_SQ;
                    p0_transpose_item(w_o, 1024, 1024, WO, scr, r, lane, 0, nullptr, false, W8_SCALE);
                }
                for (int id = gt; id < 131072; id += NGT) {
                    const int n = id & 1023, kq = id >> 10, g = kq >> 5, c0 = (kq & 31) * 4;
                    float a4[4] = {0.f, 0.f, 0.f, 0.f};
        #pragma unroll 8
                    for (int d = 0; d < 128; ++d) { const float s = pool_scale[g * 128 + d] * w_pool_up[(size_t)(g * 128 + d) * 1024 + n];
        #pragma unroll
                        for (int i = 0; i < 4; ++i) a4[i] += w_pool_grp[(size_t)(g * 128 + c0 + i) * 128 + d] * s; }
                    u32x2 w; w.x = cvtpk(a4[0], a4[1]); w.y = cvtpk(a4[2], a4[3]);
                    *(u32x2*)(WUP + (size_t)n * 1536 + 1024 + g * 128 + c0) = w;
                }
            } else {
                for (int r0 = gw; r0 < 2 * NEXP; r0 += 4 * NGW) {
                    const float* sp[4]; unsigned char* dp[4]; float* ip[4];
        #pragma unroll
                    for (int i = 0; i < 4; ++i) { int r = r0 + i * NGW; if (r >= 2 * NEXP) r = r0; const int e = r & (NEXP - 1);
                        sp[i] = ((r < NEXP) ? u_exp : v_exp) + (size_t)e * 1024; dp[i] = ((r < NEXP) ? UT : VT) + (size_t)e * 128; ip[i] = SCU + 2 * e + ((r < NEXP) ? 0 : 1); }
                    fp8_rows<4, true>(sp, dp, ip, lane);
                }
                for (int m = gw; m < T; m += 4 * NGW) rms_rows_to_bf16<4, float>(x + (size_t)m * D, (size_t)NGW * D, nullptr, XN + (size_t)m * D, lane, XH8 + (size_t)m * D, XS0 + m, (size_t)NGW, IRS + m);
            }
        }
    }
    SEAM(0);
    PH(1) if (IN(1)) {
        for (int n = gw; n < INW; n += NGW) quant_row_i8(WIN + (size_t)n * 1024, WIN8 + (size_t)n * 1024, SWIN + n, lane);
        xcd_barrier(xbar);
        pg8::Gemm g{(const bf16_t*)XH8, (const bf16_t*)WIN8, T, INW, 1024}; pg8::StaticOrder S; S.init(T, INW, G, bx, GREP(1), 1024, 0, 1);
        pg8::Epi8<FIn> E{FIn{QB, KVB, PZ, SGA, SGP, b_in, SWIN, XS0}};
        pg8::gemm_phase<pg8::Epi8<FIn>, pg8::StaticOrder, true, true, 1, true>(lds, g, S, E);
    }
    SEAM(1);
    PH(2) if (IN(2)) {
        for (int rep2 = 0; rep2 < PROBE_ATT; ++rep2)
        for (int u = bx; u < NB * 2 * 4; u += G) { const int rn = u & 3, kvh = (u >> 2) & 1, b = u >> 3; att::run(lds, QB, KVB, AOP, 1536, sinks, b, kvh, rn); }
        for (int id = gt; id < (T / 32) * 64; id += NGT) {
            const int c8 = (id & 63) * 8, ta = (id >> 6) * 32, pos0 = ta & (SEQ - 1), w = 2 << (c8 >> 7);
            const bf16_t* pzc = PZ + c8; bf16_t* plc = AOP + 1024 + c8;
            float sw[8] = {0.f, 0.f, 0.f, 0.f, 0.f, 0.f, 0.f, 0.f};
            {
                u32x4 pre[16];
#pragma unroll
                for (int i = 0; i < 16; ++i) { const bool ok = (i < w) && (pos0 - 1 - i >= 0); pre[i] = *(const u32x4*)(pzc + (size_t)(ok ? ta - 1 - i : ta) * 512); }
#pragma unroll
                for (int i = 0; i < 16; ++i) { const float m = ((i < w) && (pos0 - 1 - i >= 0)) ? 1.f : 0.f; float v[8]; unpack8(pre[i], v);
#pragma unroll
                    for (int e = 0; e < 8; ++e) sw[e] += m * v[e]; }
            }
            for (int blk = 0; blk < 4; ++blk) {
                const int tb = ta + blk * 8, pb = pos0 + blk * 8;
                u32x4 cur[8], lag[8];
#pragma unroll
                for (int i = 0; i < 8; ++i) cur[i] = *(const u32x4*)(pzc + (size_t)(tb + i) * 512);
#pragma unroll
                for (int i = 0; i < 8; ++i) { const bool ok = (pb + i - w >= 0); lag[i] = *(const u32x4*)(pzc + (size_t)(ok ? tb + i - w : tb + i) * 512); }
#pragma unroll
                for (int i = 0; i < 8; ++i) {
                    const int pos = pb + i; const float m = (pos - w >= 0) ? 1.f : 0.f;
                    float v[8], z[8]; unpack8(cur[i], v); unpack8(lag[i], z);
                    const float ic = __builtin_amdgcn_rcpf((float)((pos + 1 < w) ? pos + 1 : w));
                    float o8[8];
#pragma unroll
                    for (int e = 0; e < 8; ++e) { sw[e] += v[e] - m * z[e]; o8[e] = sw[e] * ic - v[e]; }
                    *(u32x4*)(plc + (size_t)(tb + i) * 1536) = pack8(o8);
                }
            }
        }
    }
    SEAM(2);
    PH(3) if (IN(3)) {
        pg8::Gemm g{AOP, WUP, T, 1024, 1536}; pg8::StaticOrder S; S.init(T, 1024, G, bx, GREP(3), 1024, 512);
        pg8::Epi8<FMerge> E{FMerge{SGA, SGP, MRG}};
        pg8::gemm_phase<pg8::Epi8<FMerge>, pg8::StaticOrder, true, true>(lds, g, S, E);
    }
    SEAM(3);
    PH(4) if (IN(4)) {
        pg8::Gemm g{MRG, WO, T, 1024, 1024}; pg8::StaticOrder S; S.init(T, 1024, G, bx, GREP(4), 1024, 0, 1);
        pg8::Epi8<FRes> E{FRes{XN, IRS, H}};
        pg8::gemm_phase<pg8::Epi8<FRes>, pg8::StaticOrder, true, true, 1>(lds, g, S, E);
    }
    SEAM(4);
    PH(5) if (IN(5)) { for (int n = gw; n < 2048; n += NGW) quant_row_i8(WQC + (size_t)n * 1024, WQ8 + (size_t)n * 1024, SWQ + n, lane);
        for (int m = gw; m < T; m += 4 * NGW) rms_rows_to_bf16<4, bf16_t>(H + (size_t)m * D, (size_t)NGW * D, ln_ffn_g, (bf16_t*)nullptr, lane, X8 + (size_t)m * D, XS + m, (size_t)NGW, RS2 + m); }
    SEAM(5);
    PH(6) if (IN(6)) {
        pg8::Gemm g{(const bf16_t*)X8, (const bf16_t*)WQ8, T, 2048, 1024}; pg8::StaticOrder S; S.init(T, 2048, G, bx, GREP(6), 1024, 0, 1);
        pg8::Epi8<FQP> E{FQP{(unsigned short*)QP, XS, SWQ}};
        pg8::gemm_phase<pg8::Epi8<FQP>, pg8::StaticOrder, true, true, 1, true>(lds, g, S, E);
    }
    SEAM(6);
    PH(7) if (IN(7)) {
        const int q = lane & 31, hh = lane >> 5;
        LAS unsigned char* tb = lds + tid * 36;
        for (int tile = bx; tile < T / 256; tile += G) {
            const int tok = tile * 256 + wave * 32 + q;
            const unsigned short* qsb = (const unsigned short*)QP + (size_t)((tile * 8 + wave) * 16) * 4096 + lane * 8;
            u32x4 scn[8];
#pragma unroll
            for (int c = 0; c < 8; ++c) scn[c] = *(const u32x4*)(qsb + c * 512);
            for (int hd = 0; hd < 8; ++hd) {
                unsigned S0[16], S1[16];
#pragma unroll
                for (int p = 0; p < 2; ++p) {
                    u32x4 sc[8];
#pragma unroll
                    for (int c = 0; c < 8; ++c) sc[c] = scn[c];
                    { const int un = (hd * 2 + p + 1 < 16) ? hd * 2 + p + 1 : 15;
#pragma unroll
                      for (int c = 0; c < 8; ++c) scn[c] = *(const u32x4*)(qsb + (size_t)un * 4096 + c * 512); }
                    unsigned run[16];
#pragma unroll
                    for (int blk = 0; blk < 4; ++blk) {
                        unsigned nw[16];
#pragma unroll
                        for (int dw = 0; dw < 8; ++dw) { const int c = 2 * blk + (dw >> 2), e = (dw & 3) * 2;
                            const unsigned wd = (dw & 3) == 0 ? sc[c].x : (dw & 3) == 1 ? sc[c].y : (dw & 3) == 2 ? sc[c].z : sc[c].w;
                            const unsigned x = tk::okey16x2(wd);
                            nw[2 * dw] = (x << 16) | (unsigned)(127 - (64 * hh + 8 * c + e));
                            nw[2 * dw + 1] = (x & 0xffff0000u) | (unsigned)(127 - (64 * hh + 8 * c + e + 1)); }
                        tk::sort16(nw);
                        if (blk == 0) {
#pragma unroll
                            for (int i = 0; i < 16; ++i) run[i] = nw[i];
                        } else tk::merge16(run, nw);
                    }
                    tk::merge16_xlane(run);
#pragma unroll
                    for (int i = 0; i < 16; ++i) { if (p == 0) S0[i] = run[i]; else S1[i] = run[i]; }
                }
#pragma unroll
                for (int w4 = 0; w4 < 4; ++w4) {
                    *(LAS unsigned*)(tb + 4 * w4) = (127u - (S0[4 * w4] & 127u)) | ((127u - (S0[4 * w4 + 1] & 127u)) << 8) | ((127u - (S0[4 * w4 + 2] & 127u)) << 16) | ((127u - (S0[4 * w4 + 3] & 127u)) << 24);
                    *(LAS unsigned*)(tb + 16 + 4 * w4) = (127u - (S1[4 * w4] & 127u)) | ((127u - (S1[4 * w4 + 1] & 127u)) << 8) | ((127u - (S1[4 * w4 + 2] & 127u)) << 16) | ((127u - (S1[4 * w4 + 3] & 127u)) << 24);
                }
                float va[16], vb[16];
#pragma unroll
                for (int i = 0; i < 16; ++i) { va[i] = tk::ofloat16(S0[i]); vb[i] = tk::ofloat16(S1[i]); }
                unsigned C[16];
#pragma unroll
                for (int j = 0; j < 16; ++j) C[j] = (tk::okey(va[0] + vb[j]) & ~255u) | (unsigned)(255 - j);
                {
                    unsigned g1[16], g2[16], g3[16];
#define CAND(i, j) ((tk::okey(va[i] + vb[j]) & ~255u) | (unsigned)(255 - ((i) * 16 + (j))))
                    g1[0] = CAND(1, 0); g1[1] = CAND(1, 1); g1[2] = CAND(1, 2); g1[3] = CAND(1, 3); g1[4] = CAND(1, 4); g1[5] = CAND(1, 5); g1[6] = CAND(1, 6); g1[7] = CAND(1, 7);
                    g1[8] = CAND(2, 0); g1[9] = CAND(2, 1); g1[10] = CAND(2, 2); g1[11] = CAND(2, 3); g1[12] = CAND(2, 4); g1[13] = CAND(3, 0); g1[14] = CAND(3, 1); g1[15] = CAND(3, 2);
                    g2[0] = CAND(3, 3); g2[1] = CAND(4, 0); g2[2] = CAND(4, 1); g2[3] = CAND(4, 2); g2[4] = CAND(5, 0); g2[5] = CAND(5, 1); g2[6] = CAND(6, 0); g2[7] = CAND(6, 1);
                    g2[8] = CAND(7, 0); g2[9] = CAND(7, 1); g2[10] = CAND(8, 0); g2[11] = CAND(9, 0); g2[12] = CAND(10, 0); g2[13] = CAND(11, 0); g2[14] = CAND(12, 0); g2[15] = CAND(13, 0);
                    g3[0] = CAND(14, 0); g3[1] = CAND(15, 0);
#pragma unroll
                    for (int i = 2; i < 16; ++i) g3[i] = 0u;
#undef CAND
                    tk::sort16(g1); tk::merge16(C, g1);
                    tk::sort16(g2); tk::merge16(C, g2);
                    tk::ce(g3[0], g3[1]); tk::merge16(C, g3);
                }
                const float smax = tk::ofloat(C[0] & ~255u);
                float ev[8]; unsigned ei[8]; float esum = 0.f; const unsigned hmask = 0u - (unsigned)hh;
                asm volatile("s_waitcnt lgkmcnt(0)" ::: "memory");
#pragma unroll
                for (int m = 0; m < 8; ++m) {
                    const unsigned key = C[m] ^ ((C[m] ^ C[8 + m]) & hmask);
                    const unsigned f = 255u - (key & 255u);
                    const unsigned ia = tb[f >> 4], ib = tb[16 + (f & 15u)];
                    ei[m] = ia * 128u + ib;
                    ev[m] = __builtin_amdgcn_exp2f((tk::ofloat(key & ~255u) - smax) * LOG2E); esum += ev[m];
                }
                esum += __shfl_xor(esum, 32);
                const float rden = 1.f / esum;
                u32x4 ew; ew.x = ei[0] | (ei[1] << 16); ew.y = ei[2] | (ei[3] << 16); ew.z = ei[4] | (ei[5] << 16); ew.w = ei[6] | (ei[7] << 16);
                *(u32x4*)(EID + (size_t)tok * 128 + hd * 16 + hh * 8) = ew;
                { u32x4 gw; gw.x = cvtpk(ev[0] * rden, ev[1] * rden); gw.y = cvtpk(ev[2] * rden, ev[3] * rden); gw.z = cvtpk(ev[4] * rden, ev[5] * rden); gw.w = cvtpk(ev[6] * rden, ev[7] * rden);
                  *(u32x4*)(GSM + (size_t)tok * 128 + hd * 16 + hh * 8) = gw; }
            }
        }
    }
    SEAM(7);
    PH(8) if (IN(8)) {
        const int cb = bx & 7, c = lane & 7, j = lane >> 3;
        const unsigned char* ubase = UT + (size_t)cb * (NEXP * 128) + c * 16;
        LAS int* red = (LAS int*)(lds + wave * 5120);
        unsigned short* pbase = PART + (size_t)cb * T * 128 + 2 * lane;
#define P8_ISSUE(RR, E0, E1) do { const unsigned eid_[16] = {E0.x & 0xffffu, E0.x >> 16, E0.y & 0xffffu, E0.y >> 16, E0.z & 0xffffu, E0.z >> 16, E0.w & 0xffffu, E0.w >> 16, \
                                          E1.x & 0xffffu, E1.x >> 16, E1.y & 0xffffu, E1.y >> 16, E1.z & 0xffffu, E1.z >> 16, E1.w & 0xffffu, E1.w >> 16}; \
            _Pragma("unroll") for (int i_ = 0; i_ < 16; ++i_) RR[i_] = *(const u32x4*)(ubase + (size_t)eid_[i_] * 128); } while (0)
#define P8_COMPUTE(RR, XA, XSV, TT) do { int ds[16]; \
            _Pragma("unroll") for (int i_ = 0; i_ < 16; ++i_) { int a = 0; \
                a = __builtin_amdgcn_sdot4((int)RR[i_].x, (int)XA.x, a, false); a = __builtin_amdgcn_sdot4((int)RR[i_].y, (int)XA.y, a, false); \
                a = __builtin_amdgcn_sdot4((int)RR[i_].z, (int)XA.z, a, false); a = __builtin_amdgcn_sdot4((int)RR[i_].w, (int)XA.w, a, false); ds[i_] = a; } \
              \
            { typedef int i32x4_t __attribute__((ext_vector_type(4))); typedef int i32x2_t __attribute__((ext_vector_type(2))); \
              LAS i32x4_t* rw_ = (LAS i32x4_t*)(red + lane * 20); rw_[0] = (i32x4_t){ds[0], ds[1], ds[2], ds[3]}; rw_[1] = (i32x4_t){ds[4], ds[5], ds[6], ds[7]}; rw_[2] = (i32x4_t){ds[8], ds[9], ds[10], ds[11]}; rw_[3] = (i32x4_t){ds[12], ds[13], ds[14], ds[15]}; \
              i32x2_t sm_ = (i32x2_t){0, 0}; \
              _Pragma("unroll") for (int c2_ = 0; c2_ < 8; ++c2_) sm_ += *(const LAS i32x2_t*)(red + (j * 8 + c2_) * 20 + 2 * c); \
              ds[0] = sm_.x; ds[1] = sm_.y; } \
            const float xs_ = (XSV) * 0.015625f; \
            { typedef _Float16 h2_t __attribute__((ext_vector_type(2))); const h2_t hv_ = __builtin_convertvector((f32x2_t){(float)ds[0] * xs_, (float)ds[1] * xs_}, h2_t);     \
              *(unsigned*)(pbase + (size_t)(TT) * 128) = __builtin_bit_cast(unsigned, hv_); } } while (0)
        LAS unsigned char* estg = lds + 40960 + wave * 2048;
#define P8_EIDS(E0, E1, U) do { E0 = *(const LAS u32x4*)(estg + ((U) & 7) * 256 + j * 32); E1 = *(const LAS u32x4*)(estg + ((U) & 7) * 256 + j * 32 + 16); } while (0)
        LAS unsigned char* xstg = lds + 98304 + wave * 1024;
        const signed char* xg8 = X8 + cb * 128 + (size_t)(lane >> 3) * 1024 + (lane & 7) * 16;
#define P8_XLD(U) (*(const LAS u32x4*)(xstg + ((U) & 7) * 128 + c * 16))
        for (int sh = bx >> 3; sh < 32; sh += (G >> 3)) {
            const int t0 = sh * 2048 + wave * 256, tl = t0 + 255;
            u32x4 rrA[16], rrB[16];
            const unsigned short* eg = EID + (size_t)t0 * 128 + lane * 16;
            u32x4 n0 = *(const u32x4*)eg, n1 = *(const u32x4*)(eg + 8);
            *(LAS u32x4*)(estg + lane * 32) = n0; *(LAS u32x4*)(estg + lane * 32 + 16) = n1;
            n0 = *(const u32x4*)(eg + 1024); n1 = *(const u32x4*)(eg + 1024 + 8);
            u32x4 nx = *(const u32x4*)(xg8 + (size_t)t0 * 1024);
            *(LAS u32x4*)(xstg + lane * 16) = nx;
            nx = *(const u32x4*)(xg8 + (size_t)(t0 + 8) * 1024);
            u32x4 e0, e1;
            P8_EIDS(e0, e1, 0);
            u32x4 xA = P8_XLD(0); float sA = XS[t0];
            P8_ISSUE(rrA, e0, e1);
            u32x4 xB; float sB = XS[t0 + 1];
            for (int tt = 0; tt < 256; tt += 2) {
                const int t = t0 + tt, t2 = (t + 2 < tl) ? t + 2 : tl, t3 = (t + 3 < tl) ? t + 3 : tl;
                P8_EIDS(e0, e1, tt + 1); xB = P8_XLD(tt + 1); P8_ISSUE(rrB, e0, e1);
                if ((tt & 7) == 6) {
                    *(LAS u32x4*)(estg + lane * 32) = n0; *(LAS u32x4*)(estg + lane * 32 + 16) = n1; *(LAS u32x4*)(xstg + lane * 16) = nx;
                    const int nb = ((tt >> 3) + 2 < 31) ? (tt >> 3) + 2 : 31;
                    n0 = *(const u32x4*)(eg + nb * 1024); n1 = *(const u32x4*)(eg + nb * 1024 + 8); nx = *(const u32x4*)(xg8 + (size_t)(t0 + nb * 8) * 1024);
                }
                P8_COMPUTE(rrA, xA, sA, t);
                sA = XS[t2];
                P8_EIDS(e0, e1, t2 - t0); xA = P8_XLD(t2 - t0); P8_ISSUE(rrA, e0, e1);
                P8_COMPUTE(rrB, xB, sB, t + 1);
                sB = XS[t3];
            }
        }
#undef P8_EIDS
#undef P8_XLD
#undef P8_ISSUE
#undef P8_COMPUTE
    }
    SEAM(8);
    PH(9) if (IN(9)) {
        typedef _Float16 h2_t __attribute__((ext_vector_type(2)));
#define P9_LOAD(PV, E2, G2, T0) do { _Pragma("unroll") for (int r = 0; r < 4; ++r) { const int t = (T0) + r * NGW; \
            _Pragma("unroll") for (int k = 0; k < 8; ++k) PV[r][k] = *(const unsigned*)(PART + ((size_t)k * T + t) * 128 + 2 * lane); \
            E2[r] = *(const unsigned*)(EID + (size_t)t * 128 + lane * 2); G2[r] = *(const unsigned*)(GSM + (size_t)t * 128 + lane * 2); } } while (0)
#define P9_SCALES(SC, E2) do { _Pragma("unroll") for (int r = 0; r < 4; ++r) { SC[r][0] = *(const f32x2_t*)(SCU + 2 * (E2[r] & 0xffffu)); SC[r][1] = *(const f32x2_t*)(SCU + 2 * (E2[r] >> 16)); } } while (0)
        unsigned pv[4][8], e2[4], g2[4], pvn[4][8], e2n[4], g2n[4]; f32x2_t sc[4][2], scn[4][2];
        int t0 = gw;
        if (t0 < T) { P9_LOAD(pv, e2, g2, t0); P9_SCALES(sc, e2); }
        for (; t0 < T; t0 += 4 * NGW) {
            const int tn = (t0 + 4 * NGW < T) ? t0 + 4 * NGW : t0;
            P9_LOAD(pvn, e2n, g2n, tn);
#pragma unroll
            for (int r = 0; r < 4; ++r) { const int t = t0 + r * NGW;
                f32x2_t p8[8];
#pragma unroll
                for (int k = 0; k < 8; ++k) p8[k] = __builtin_convertvector(__builtin_bit_cast(h2_t, pv[r][k]), f32x2_t);
                const f32x2_t sm = (p8[0] + p8[1]) + (p8[2] + p8[3]) + ((p8[4] + p8[5]) + (p8[6] + p8[7]));
                const float w0 = bf_lo(g2[r]) * gelu_erf(sm.x * (sc[r][0].x * 64.f)) * sc[r][0].y, w1 = bf_hi(g2[r]) * gelu_erf(sm.y * (sc[r][1].x * 64.f)) * sc[r][1].y;
                float am = fmaxf(fabsf(w0), fabsf(w1));
#pragma unroll
                for (int o = 1; o < 64; o <<= 1) am = fmaxf(am, __shfl_xor(am, o));
                const float qs = am > 0.f ? 127.f / am : 0.f;
                const int q0 = __float2int_rn(w0 * qs), q1 = __float2int_rn(w1 * qs);
                *(unsigned short*)(GS8 + (size_t)t * 128 + lane * 2) = (unsigned short)((q0 & 0xff) | ((q1 & 0xff) << 8));
                if (lane == 0) WSC[t] = am * (1.f / 127.f); }
            P9_SCALES(scn, e2n);
#pragma unroll
            for (int r = 0; r < 4; ++r) { e2[r] = e2n[r]; g2[r] = g2n[r]; sc[r][0] = scn[r][0]; sc[r][1] = scn[r][1];
#pragma unroll
                for (int k = 0; k < 8; ++k) pv[r][k] = pvn[r][k]; }
        }
#undef P9_LOAD
#undef P9_SCALES
    }
    SEAM(9);
    PH(10) if (IN(10)) {
        const int cb = bx & 7, c = lane & 7, j = lane >> 3;
        const unsigned char* vbase = VT + (size_t)cb * (NEXP * 128) + c * 16;
        const int col = cb * 128 + c * 16 + 2 * j;
        LAS unsigned char* estg = lds + 139264 + wave * 2048;
#define P10_EIDS(E0, E1, U) do { E0 = *(const LAS u32x4*)(estg + ((U) & 7) * 256 + j * 32); E1 = *(const LAS u32x4*)(estg + ((U) & 7) * 256 + j * 32 + 16); } while (0)
        LAS unsigned* ybuf = (LAS unsigned*)(lds + wave * 12288);
        LAS float* sqbuf = (LAS float*)(lds + wave * 12288 + 8192);
        LAS int* red = (LAS int*)(lds + 98304 + wave * 5120);
        const f32x2_t gfin = *(const f32x2_t*)(ln_final_g + col);
        typedef int i32x4_t __attribute__((ext_vector_type(4))); typedef int i32x2_t __attribute__((ext_vector_type(2)));
        unsigned sello[4], selhi[4];
#pragma unroll
        for (int s_ = 0; s_ < 4; ++s_) { const unsigned z = 0x0c0c0c0cu, one = z ^ ((0x0cu ^ (unsigned)s_) << (8 * (c & 3))); sello[s_] = (c < 4) ? one : z; selhi[s_] = (c < 4) ? z : one; }
        const int rdo = (((j >> 1) & 1) * 16 + c) * 8 + (j >> 2) * 4 + (j & 1) * 2;
#define P10_ISSUE(RR, E0, E1) do { const unsigned eid_[16] = {E0.x & 0xffffu, E0.x >> 16, E0.y & 0xffffu, E0.y >> 16, E0.z & 0xffffu, E0.z >> 16, E0.w & 0xffffu, E0.w >> 16, \
                                          E1.x & 0xffffu, E1.x >> 16, E1.y & 0xffffu, E1.y >> 16, E1.z & 0xffffu, E1.z >> 16, E1.w & 0xffffu, E1.w >> 16}; \
            _Pragma("unroll") for (int i_ = 0; i_ < 16; ++i_) RR[i_] = *(const u32x4*)(vbase + (size_t)eid_[i_] * 128); } while (0)
        LAS unsigned char* wstg = lds + 98304 + wave * 5120 + 2048;
#define P10_WLD(U) (*(const LAS u32x4*)(wstg + ((U) & 7) * 128 + j * 16))
#define P10_COMPUTE(RR, W, WS_, H2, TT, SLOT) do { i32x4_t a1_ = (i32x4_t){0, 0, 0, 0}, a2_ = (i32x4_t){0, 0, 0, 0}; \
            const unsigned wd_[4] = {W.x, W.y, W.z, W.w}; \
            _Pragma("unroll") for (int i_ = 0; i_ < 16; ++i_) { \
                const unsigned alo_ = __builtin_amdgcn_perm(wd_[i_ >> 2], wd_[i_ >> 2], sello[i_ & 3]), ahi_ = __builtin_amdgcn_perm(wd_[i_ >> 2], wd_[i_ >> 2], selhi[i_ & 3]); \
                const long av_ = (long)(((unsigned long)ahi_ << 32) | alo_); \
                const long b1_ = (long)(((unsigned long)RR[i_].y << 32) | RR[i_].x), b2_ = (long)(((unsigned long)RR[i_].w << 32) | RR[i_].z); \
                a1_ = __builtin_amdgcn_mfma_i32_16x16x32_i8(av_, b1_, a1_, 0, 0, 0); a2_ = __builtin_amdgcn_mfma_i32_16x16x32_i8(av_, b2_, a2_, 0, 0, 0); } \
              \
            { LAS i32x4_t* rw_ = (LAS i32x4_t*)(red + lane * 8); rw_[0] = a1_; rw_[1] = a2_; \
              const i32x2_t sa_ = *(const LAS i32x2_t*)(red + rdo), sb_ = *(const LAS i32x2_t*)(red + rdo + 40 * 8); \
              const f32x2_t y = (f32x2_t){bf_lo(H2) + (float)(sa_.x + sb_.x) * WS_, bf_hi(H2) + (float)(sa_.y + sb_.y) * WS_};     \
              ybuf[(SLOT) * 64 + lane] = cvtpk(y.x, y.y); \
              sqbuf[((SLOT) & 15) * 64 + lane] = y.x * y.x + y.y * y.y; } } while (0)
#define P10_FINAL(TB, SB, CW) do { { unsigned sp_ = 0; while (__hip_atomic_load((CW), __ATOMIC_RELAXED, __HIP_MEMORY_SCOPE_AGENT) < 8u) { __builtin_amdgcn_s_sleep(2); if (++sp_ > (1u << 22)) break; } } \
            float rs_ = 1.f; if (lane < 16) rs_ = 1.f / sqrtf(__hip_atomic_load(SS + (TB) + lane, __ATOMIC_RELAXED, __HIP_MEMORY_SCOPE_AGENT) * (1.f / D) + EPS); \
            _Pragma("unroll") for (int k_ = 0; k_ < 16; ++k_) { const float r_ = __uint_as_float(__builtin_amdgcn_readlane(__float_as_uint(rs_), k_)); const unsigned yw_ = ybuf[((SB) + k_) * 64 + lane]; \
                *(f32x2_t*)(out + (size_t)((TB) + k_) * 1024 + col) = (f32x2_t){bf_lo(yw_) * r_ * gfin.x, bf_hi(yw_) * r_ * gfin.y}; } } while (0)
        for (int sh = bx >> 3; sh < 32; sh += (G >> 3)) {
            const int t0 = sh * 2048 + wave * 256, tl = t0 + 255;
            unsigned* cw = CNT + (sh * 8 + wave) * 16;
            u32x4 rrA[16], rrB[16]; u32x4 wA, wB; float sA, sB;
            const unsigned short* eg = EID + (size_t)t0 * 128 + lane * 16;
            u32x4 n0 = *(const u32x4*)eg, n1 = *(const u32x4*)(eg + 8);
            *(LAS u32x4*)(estg + lane * 32) = n0; *(LAS u32x4*)(estg + lane * 32 + 16) = n1;
            n0 = *(const u32x4*)(eg + 1024); n1 = *(const u32x4*)(eg + 1024 + 8);
            const signed char* wg8 = GS8 + (size_t)t0 * 128 + lane * 16;
            u32x4 nw = *(const u32x4*)wg8;
            *(LAS u32x4*)(wstg + lane * 16) = nw;
            nw = *(const u32x4*)(wg8 + 1024);
            u32x4 e0, e1;
            P10_EIDS(e0, e1, 0);
            wA = P10_WLD(0); sA = WSC[t0];
            unsigned hA = *(const unsigned*)(H + (size_t)t0 * 1024 + col);
            P10_ISSUE(rrA, e0, e1);
            sB = WSC[t0 + 1];
            unsigned hB = *(const unsigned*)(H + (size_t)(t0 + 1) * 1024 + col);
            for (int tt = 0; tt < 256; tt += 2) {
                const int t = t0 + tt, t2 = (t + 2 < tl) ? t + 2 : tl, t3 = (t + 3 < tl) ? t + 3 : tl;
                P10_EIDS(e0, e1, tt + 1); wB = P10_WLD(tt + 1); P10_ISSUE(rrB, e0, e1);
                if ((tt & 7) == 6) {
                    *(LAS u32x4*)(estg + lane * 32) = n0; *(LAS u32x4*)(estg + lane * 32 + 16) = n1; *(LAS u32x4*)(wstg + lane * 16) = nw;
                    const int nb = ((tt >> 3) + 2 < 31) ? (tt >> 3) + 2 : 31;
                    n0 = *(const u32x4*)(eg + nb * 1024); n1 = *(const u32x4*)(eg + nb * 1024 + 8); nw = *(const u32x4*)(wg8 + nb * 1024);
                }
                P10_COMPUTE(rrA, wA, sA, hA, t, tt & 31);
                sA = WSC[t2]; hA = *(const unsigned*)(H + (size_t)t2 * 1024 + col);
                P10_EIDS(e0, e1, t2 - t0); wA = P10_WLD(t2 - t0); P10_ISSUE(rrA, e0, e1);
                P10_COMPUTE(rrB, wB, sB, hB, t + 1, (tt + 1) & 31);
                sB = WSC[t3]; hB = *(const unsigned*)(H + (size_t)t3 * 1024 + col);
                if ((tt & 15) == 14) {
                    const int b = tt >> 4;
                    { float sq16[16];
#pragma unroll
                      for (int k = 0; k < 16; ++k) sq16[k] = sqbuf[k * 64 + lane];
                      const float tot = reduce16(sq16, lane);
                      if ((lane & 3) == 0) atomicAdd(SS + t0 + b * 16 + ((lane >> 2) & 15), tot); }
                    asm volatile("s_waitcnt vmcnt(0)" ::: "memory");
                    if (lane == 0) __hip_atomic_fetch_add(cw + b, 1u, __ATOMIC_RELAXED, __HIP_MEMORY_SCOPE_AGENT);
                    if (b > 0) P10_FINAL(t0 + (b - 1) * 16, ((b - 1) & 1) * 16, cw + (b - 1));
                }
            }
            P10_FINAL(t0 + 240, 16, cw + 15);
        }
#undef P10_ISSUE
#undef P10_EIDS
#undef P10_WLD
#undef P10_COMPUTE
#undef P10_FINAL
    }
#undef IN
#undef SEAM
}

#ifndef N_LAUNCHES
#define N_LAUNCHES 1
#endif
extern "C" void kernel_launch(void* const* d_in, const int* in_sizes, int n_in, void* d_out, int out_size, void* d_ws, size_t ws_size, hipStream_t stream) {
    static int grid = 0;
    if (grid == 0) {
        if (n_in != 16 || out_size != T * D || ws_size < WS_END) { fprintf(stderr, "kernel_launch: unexpected shapes: n_in %d out %d ws %zu\n", n_in, out_size, ws_size); grid = -1; return; }
        int dev = 0, cus = 0, per_cu = 0;
        (void)hipGetDevice(&dev); (void)hipDeviceGetAttribute(&cus, hipDeviceAttributeMultiprocessorCount, dev);
        (void)hipFuncSetAttribute((const void*)fwd, hipFuncAttributeMaxDynamicSharedMemorySize, LDS_BYTES);
        (void)hipOccupancyMaxActiveBlocksPerMultiprocessor(&per_cu, (const void*)fwd, 512, LDS_BYTES);
        (void)hipGetLastError();
        if (per_cu < 1) { fprintf(stderr, "kernel_launch: occupancy query says %d blocks/CU\n", per_cu); grid = -1; return; }
        grid = cus;
        fprintf(stderr, "kernel_launch: grid %d (cus %d, per_cu %d)\n", grid, cus, per_cu);
    }
    if (grid < 0) return;
    if (hipMemsetAsync((char*)d_ws + WS_CTL, 0, 1048576, stream) != hipSuccess) { fprintf(stderr, "kernel_launch: hipMemsetAsync failed\n"); return; }
    Args a{};
    for (int i = 0; i < 16; ++i) a.in[i] = (const float*)d_in[i];
    a.out = (float*)d_out; a.ws = (unsigned char*)d_ws;
    constexpr int NPH = 11;
    for (int li = 0; li < N_LAUNCHES; ++li) {
        a.ph_lo = (N_LAUNCHES == 1) ? 0 : li; a.ph_hi = (N_LAUNCHES == 1) ? NPH : li + 1;
        void* kargs[] = {&a};
        hipError_t e = hipLaunchCooperativeKernel((const void*)fwd, dim3(grid), dim3(512), kargs, LDS_BYTES, stream);
        if (e != hipSuccess) { fprintf(stderr, "kernel_launch: cooperative launch failed: %s (grid %d)\n", hipGetErrorString(e), grid); break; }
    }
}
```

```cpp
#include <hip/hip_runtime.h>
#include <hip/hip_cooperative_groups.h>
#include <cstdio>
#include <cstdint>
namespace cg = cooperative_groups;

#define GAS __attribute__((address_space(1)))
#define LAS __attribute__((address_space(3)))
typedef unsigned short bf16_t;
typedef short bf16x8 __attribute__((ext_vector_type(8)));
typedef float f32x4 __attribute__((ext_vector_type(4)));
typedef float f32x16 __attribute__((ext_vector_type(16)));
typedef unsigned u32x4 __attribute__((ext_vector_type(4)));
typedef unsigned u32x2 __attribute__((ext_vector_type(2)));
typedef float f32x2_t __attribute__((ext_vector_type(2)));
typedef __bf16 bf16x2_t __attribute__((ext_vector_type(2)));

__device__ __forceinline__ unsigned cvtpk(float lo, float hi) { f32x2_t v = {lo, hi}; bf16x2_t b = __builtin_convertvector(v, bf16x2_t); return __builtin_bit_cast(unsigned, b); }
__device__ __forceinline__ float bf_lo(unsigned d) { return __uint_as_float(d << 16); }
__device__ __forceinline__ float bf_hi(unsigned d) { return __uint_as_float(d & 0xffff0000u); }
__device__ __forceinline__ float dot2bf(unsigned a, unsigned b, float c) { return __builtin_amdgcn_fdot2_f32_bf16(__builtin_bit_cast(bf16x2_t, a), __builtin_bit_cast(bf16x2_t, b), c, false); }
__device__ __forceinline__ unsigned fp8x2_to_bf16x2(unsigned s, bool hi) { return hi ? __builtin_bit_cast(unsigned, __builtin_amdgcn_cvt_scalef32_pk_bf16_fp8(s, 1.0f, true)) : __builtin_bit_cast(unsigned, __builtin_amdgcn_cvt_scalef32_pk_bf16_fp8(s, 1.0f, false)); }
__device__ __forceinline__ float wave_sum(float v) {
#pragma unroll
    for (int o = 1; o < 64; o <<= 1) v += __shfl_xor(v, o);
    return v;
}

template <int CTRL> __device__ __forceinline__ float dpp_f(float v) { return __builtin_bit_cast(float, __builtin_amdgcn_update_dpp(0, __builtin_bit_cast(int, v), CTRL, 0xf, 0xf, false)); }
__device__ __forceinline__ float rl_f(float v, int l) { return __builtin_bit_cast(float, __builtin_amdgcn_readlane(__builtin_bit_cast(int, v), l)); }
__device__ __forceinline__ float wave_max(float v) {
    v = fmaxf(v, dpp_f<0xB1>(v)); v = fmaxf(v, dpp_f<0x4E>(v)); v = fmaxf(v, dpp_f<0x141>(v)); v = fmaxf(v, dpp_f<0x140>(v));
    return fmaxf(fmaxf(rl_f(v, 0), rl_f(v, 16)), fmaxf(rl_f(v, 32), rl_f(v, 48)));
}

constexpr int T = 65536, D = 1024, SEQ = 2048, NB = 32;
constexpr int INW = 3840, NEXP = 16384;
constexpr float EPS = 1e-5f;
constexpr float LOG2E = 1.4426950408889634f;
constexpr float QSCALE = 0.125f * LOG2E;
constexpr float AO_CLIP = 4.f;
constexpr float W8_SCALE = 64.f, MRG_SCALE = 16.f;

constexpr size_t MiB = 1u << 20;
constexpr size_t WS_CTL = 0;
constexpr size_t WS_WIN = 1 * MiB;
constexpr size_t WS_WUP = 9 * MiB;
constexpr size_t WS_WPU = 11 * MiB;
constexpr size_t WS_WO = 12 * MiB;
constexpr size_t WS_WQC = 56 * MiB;
constexpr size_t WS_SK = 18 * MiB;
constexpr size_t WS_SCU = 19 * MiB;
constexpr size_t WS_SCV = 19 * MiB + 65536;
constexpr size_t WS_U = 32 * MiB;
constexpr size_t WS_V = 64 * MiB;
constexpr size_t WS_XN = 96 * MiB;
constexpr size_t WS_Q = 224 * MiB;
constexpr size_t WS_AO = 352 * MiB;
constexpr size_t WS_KV = 480 * MiB;
constexpr size_t WS_PZ = 512 * MiB;
constexpr size_t WS_PL = 576 * MiB;
constexpr size_t WS_H = 480 * MiB;
constexpr size_t WS_SGA = 640 * MiB;
constexpr size_t WS_SGP = 768 * MiB;
constexpr size_t WS_EID = 768 * MiB;
constexpr size_t WS_GSM = 800 * MiB;
constexpr size_t WS_GS8 = 816 * MiB;
constexpr size_t WS_WSC = 832 * MiB;
constexpr size_t WS_WIN8 = 24 * MiB;
constexpr size_t WS_SWIN = 28 * MiB;
constexpr size_t WS_WC8 = 16 * MiB;
constexpr size_t WS_SWC = 18 * MiB;
constexpr size_t WS_SPL = 22 * MiB;
constexpr size_t WS_WQ8 = 29 * MiB;
constexpr size_t WS_SWQ = 31 * MiB;
constexpr size_t WS_XH8 = 96 * MiB;
constexpr size_t WS_XS0 = 21 * MiB + 512 * 1024;
constexpr size_t WS_X8 = 896 * MiB;
constexpr size_t WS_XS = 20 * MiB;
constexpr size_t WS_END = 1024 * MiB;

constexpr int LDS_BYTES = 163840;

namespace pg8 {
typedef int i32x4_t __attribute__((ext_vector_type(4))); typedef int i32x8_t __attribute__((ext_vector_type(8)));
constexpr int BM = 256, BK = 64, HALF = 128, HTB = HALF * BK * 2, STAGE_BYTES = 8 * HTB, NXCD = 8, WGM = 8;
__host__ __device__ __forceinline__ int lds_byte(int r, int c) { const int st = (r >> 4) * 2 + (c >> 5), rr = r & 15, cc = c & 31, ob = rr * 64 + cc * 2; return st * 1024 + (ob ^ (((ob >> 9) & 1) << 5)); }
__host__ __device__ __forceinline__ void stage_rc(int b, int& R, int& C) { const int st = b / 1024, sb = b % 1024, swz = sb ^ (((sb >> 9) & 1) << 5); R = (st >> 1) * 16 + swz / 64; C = (st & 1) * 32 + (swz % 64) / 2; }
__host__ __device__ __forceinline__ int perm32(int rho) { const int n = rho >> 4, i = rho & 15; return 8 * (i >> 2) + 4 * n + (i & 3); }
struct Unit { int pm, pn, kofs, nt, seg; };
struct Gemm { const bf16_t* A; const bf16_t* Bt; int M, N, K; };
struct StaticOrder {
    int nM, nN, nwg, G, c, rep, nun, nseg, k0, k1, esz;
    __host__ __device__ void init(int M, int N, int G_, int c_, int rep_ = 1, int K0 = 0, int K1 = 0, int esz_ = 2) { nM = M / BM; nN = N / BM; nwg = nM * nN; G = G_; c = c_; rep = rep_; nun = (nwg - c + G - 1) / G; nseg = K1 ? 2 : 1; k0 = K0; k1 = K1; esz = esz_; }
    __host__ __device__ bool next(int i, Unit& u) const {
        const int iu = i / nseg, sg = i - iu * nseg;
        if (iu >= rep * nun) return false;
        const long L = (long)(iu % nun) * G + c; if (L >= nwg) return false;
        int wgid = (int)L; { const int q = nwg / NXCD, r = nwg % NXCD, xcd = wgid % NXCD, off = wgid / NXCD; wgid = (xcd < r ? xcd * (q + 1) : r * (q + 1) + (xcd - r) * q) + off; }
        const int nig = WGM * nN, gid = wgid / nig, fm = gid * WGM, gsz = (nM - fm) < WGM ? (nM - fm) : WGM;
        u.pm = fm + ((wgid % nig) % gsz); u.pn = (wgid % nig) / gsz;
        u.seg = sg; u.kofs = sg ? k0 * esz : 0; u.nt = ((sg ? k1 : k0) * esz) / (BK * 2); return true;
    }
    __device__ __forceinline__ void a_ready(const Unit&) const {}
    __device__ __forceinline__ void done(const Unit&) const {}
};
struct NoPre {};
template <class F> struct Epi8 {
    static constexpr bool PERM = true, AFTER_DRAIN = false;
    F f;
    __device__ __forceinline__ bool operator()(f32x4 (&acc)[2][2][4][2], const Unit& u, int wr, int wc, int fr, int fq) const {
        const int row0 = u.pm * BM + wr * 64 + fr, col0 = u.pn * BM + wc * 32 + 8 * fq;
        const bool seam = F::SEGS == 2 && u.seg == 0;
        typename F::TilePre tp; f.tile_preload(row0, col0, u.pn, tp);
#pragma unroll
        for (int ai = 0; ai < 2; ++ai) {
            typename F::Pre pre[4][2];
            float rs4[4] = {1.f, 1.f, 1.f, 1.f};
            if constexpr (F::IACC) {
#pragma unroll
                for (int m = 0; m < 4; ++m) rs4[m] = f.row_scale(row0 + ai * HALF + m * 16);
            }
#pragma unroll
            for (int m = 0; m < 4; ++m)
#pragma unroll
                for (int bj = 0; bj < 2; ++bj) { if (seam) f.preload_seam(row0 + ai * HALF + m * 16, col0 + bj * HALF, pre[m][bj]); else f.preload(row0 + ai * HALF + m * 16, col0 + bj * HALF, pre[m][bj]); }
#pragma unroll
            for (int m = 0; m < 4; ++m)
#pragma unroll
                for (int bj = 0; bj < 2; ++bj) {
                    if (F::PAIRED && bj == 1) continue;
                    const f32x4 a = acc[ai][bj][m][0], b = acc[ai][bj][m][1];
                    float v[8] = {a[0], a[1], a[2], a[3], b[0], b[1], b[2], b[3]};
                    if (F::PAIRED) { const f32x4 a1 = acc[ai][1][m][0], b1 = acc[ai][1][m][1]; float v1[8] = {a1[0], a1[1], a1[2], a1[3], b1[0], b1[1], b1[2], b1[3]};
                        if constexpr (F::IACC) { const float rs = rs4[m];
#pragma unroll
                            for (int i = 0; i < 8; ++i) { v[i] = (float)__float_as_int(v[i]) * rs; v1[i] = (float)__float_as_int(v1[i]) * rs; } }
                        f.pair(row0 + ai * HALF + m * 16, col0, u.pn, v, v1, tp); continue; }
                    if (seam) { if constexpr (F::IACC) f.seam_i(col0 + bj * HALF, v, pre[m][bj], tp, bj); else f.seam(row0 + ai * HALF + m * 16, col0 + bj * HALF, v, pre[m][bj]);
                        acc[ai][bj][m][0] = (f32x4){v[0], v[1], v[2], v[3]}; acc[ai][bj][m][1] = (f32x4){v[4], v[5], v[6], v[7]}; }
                    else { if constexpr (F::IACC) {
#pragma unroll
                               for (int i = 0; i < 8; ++i) v[i] = (float)__float_as_int(v[i]) * rs4[m]; }
                           f(row0 + ai * HALF + m * 16, col0 + bj * HALF, u.pn, v, pre[m][bj], tp, bj); }
                }
        }
        return !seam;
    }
};

template <class Epi, class Sched, bool ALIGN_EPI = false, bool SP2 = false, int ESZ = 2, bool I8 = false>
__device__ __forceinline__ void gemm_phase(LAS unsigned char* lds, const Gemm g, const Sched& S, const Epi& E) {
    if (blockIdx.x & 8) { __builtin_amdgcn_s_sleep(127); __builtin_amdgcn_s_sleep(127); }
    int tid = threadIdx.x; asm volatile("" : "+v"(tid));
    const int wid = __builtin_amdgcn_readfirstlane(tid >> 6), lane = tid & 63, wr = wid >> 2, wc = wid & 3, fr = lane & 15, fq = lane >> 4;
    const int K = g.K;
    unsigned voffA[2], voffB[2];
#pragma unroll
    for (int i = 0; i < 2; ++i) { int R, C; stage_rc(tid * 16 + i * 8192, R, C); const int Rb = Epi::PERM ? ((R & ~31) + perm32(R & 31)) : R;
        voffA[i] = (unsigned)(R * K * ESZ + C * 2); voffB[i] = (unsigned)(Rb * K * ESZ + C * 2); }
    const size_t kstep = (size_t)(BK * 2);
    const size_t hstep = (size_t)HALF * K * ESZ;
    const size_t tstep = 2 * hstep;
    const unsigned ldsw = (unsigned)wid * 1024u;
    const int aoff = lds_byte(wr * 64 + fr, fq * 8), boff = lds_byte(wc * 32 + fr, fq * 8);
#define PG8_SA(b, h) (((b) * 2 + (h)) * HTB)
#define PG8_SB(b, h) ((4 + (b) * 2 + (h)) * HTB)
#define PG8_STAGE(bufoff, gbase, voff) do { _Pragma("unroll") for (int _i = 0; _i < 2; ++_i) \
        __builtin_amdgcn_global_load_lds((const unsigned*)((const char*)(gbase) + (voff)[_i]), (LAS unsigned*)(lds + (bufoff) + ldsw + _i * 8192), 16, 0, 0); } while (0)
#define PG8_LDA(dst, b, h) do { _Pragma("unroll") for (int m = 0; m < 4; ++m) { dst[m].lo = *(const LAS i32x4_t*)(lds + PG8_SA(b, h) + aoff + m * 2048); dst[m].hi = *(const LAS i32x4_t*)(lds + PG8_SA(b, h) + aoff + m * 2048 + 1024); } } while (0)
#define PG8_LDB(dst, b, h) do { _Pragma("unroll") for (int n = 0; n < 2; ++n) { dst[n].lo = *(const LAS i32x4_t*)(lds + PG8_SB(b, h) + boff + n * 2048); dst[n].hi = *(const LAS i32x4_t*)(lds + PG8_SB(b, h) + boff + n * 2048 + 1024); } } while (0)
#define PG8_MMA(ai, bj, At, Bt) do { __builtin_amdgcn_s_setprio(1); _Pragma("unroll") for (int m = 0; m < 4; ++m) _Pragma("unroll") for (int n = 0; n < 2; ++n) { \
        if constexpr (ESZ == 1 && !I8) asm volatile("v_mfma_scale_f32_16x16x128_f8f6f4 %0, %1, %2, %0, %3, %3 op_sel_hi:[0,0,0]" : "+v"(acc[ai][bj][m][n]) : "v"(Bt[n]), "v"(At[m]), "v"(f8one));     \
        else if constexpr (I8) { const i32x4_t bl_ = Bt[n].lo, bh_ = Bt[n].hi, al_ = At[m].lo, ah_ = At[m].hi; const f32x4 t_ = acc[ai][bj][m][n]; i32x4_t c_ = __builtin_bit_cast(i32x4_t, t_);     \
               c_ = __builtin_amdgcn_mfma_i32_16x16x64_i8(bl_, al_, c_, 0, 0, 0); c_ = __builtin_amdgcn_mfma_i32_16x16x64_i8(bh_, ah_, c_, 0, 0, 0); acc[ai][bj][m][n] = __builtin_bit_cast(f32x4, c_); } \
        else { const i32x4_t bl_ = Bt[n].lo, bh_ = Bt[n].hi, al_ = At[m].lo, ah_ = At[m].hi;     \
               acc[ai][bj][m][n] = __builtin_amdgcn_mfma_f32_16x16x32_bf16(__builtin_bit_cast(bf16x8, bl_), __builtin_bit_cast(bf16x8, al_), acc[ai][bj][m][n], 0, 0, 0); \
               acc[ai][bj][m][n] = __builtin_amdgcn_mfma_f32_16x16x32_bf16(__builtin_bit_cast(bf16x8, bh_), __builtin_bit_cast(bf16x8, ah_), acc[ai][bj][m][n], 0, 0, 0); } } \
        if constexpr (ESZ == 1 && !I8) asm volatile("s_nop 7" ::: "memory"); __builtin_amdgcn_s_setprio(0); } while (0)
#define PG8_WAIT_V(n) asm volatile("s_waitcnt vmcnt(" #n ")" ::: "memory")
#define PG8_WAIT_L(n) asm volatile("s_waitcnt lgkmcnt(" #n ")" ::: "memory")
#define PG8_BAR __builtin_amdgcn_s_barrier()
#define PG8_SCHED __builtin_amdgcn_sched_barrier(0)
    Unit cur, nxt; int ui = 0;
    if (!S.next(0, cur)) return;
    f32x4 acc[2][2][4][2];
#pragma unroll
    for (int a = 0; a < 2; ++a)
#pragma unroll
        for (int b = 0; b < 2; ++b)
#pragma unroll
            for (int m = 0; m < 4; ++m)
#pragma unroll
                for (int n = 0; n < 2; ++n) acc[a][b][m][n] = (f32x4){0.f, 0.f, 0.f, 0.f};
    int f8one = 0x7f7f7f7f; if constexpr (ESZ == 1 && !I8) asm volatile("" : "+v"(f8one));
    i32x8_t At[4], B0[2], B1[2];
    const char* cA = (const char*)g.A + (size_t)cur.pm * tstep + cur.kofs; const char* cB = (const char*)g.Bt + (size_t)cur.pn * tstep + cur.kofs;
    S.a_ready(cur);
    if constexpr (SP2) {
        PG8_STAGE(PG8_SB(0, 0), cB, voffB); PG8_STAGE(PG8_SB(0, 1), cB + hstep, voffB); PG8_STAGE(PG8_SA(0, 0), cA, voffA); PG8_STAGE(PG8_SA(0, 1), cA + hstep, voffA);
        if (wr == 1) PG8_BAR;
        PG8_WAIT_V(2); PG8_BAR;
        PG8_STAGE(PG8_SB(1, 0), cB + kstep, voffB); PG8_STAGE(PG8_SA(1, 0), cA + kstep, voffA); PG8_STAGE(PG8_SB(1, 1), cB + hstep + kstep, voffB);
        PG8_WAIT_V(6); PG8_BAR;
    } else {
        PG8_STAGE(PG8_SB(0, 0), cB, voffB); PG8_STAGE(PG8_SA(0, 0), cA, voffA); PG8_STAGE(PG8_SB(0, 1), cB + hstep, voffB); PG8_STAGE(PG8_SA(0, 1), cA + hstep, voffA);
        if (wr == 1) PG8_BAR;
        PG8_WAIT_V(4); PG8_BAR;
        PG8_STAGE(PG8_SB(1, 0), cB + kstep, voffB); PG8_STAGE(PG8_SA(1, 0), cA + kstep, voffA); PG8_STAGE(PG8_SB(1, 1), cB + hstep + kstep, voffB);
        PG8_WAIT_V(6); PG8_BAR;
    }
    for (;;) {
        const bool has_next = S.next(ui + 1, nxt);
        const char* nA = has_next ? (const char*)g.A + (size_t)nxt.pm * tstep + nxt.kofs : cA; const char* nB = has_next ? (const char*)g.Bt + (size_t)nxt.pn * tstep + nxt.kofs : cB;
        const int nt = cur.nt;
        for (int t = 0; t < nt; t += 2) {
            const bool last = (t == nt - 2);
            const char* a1 = cA + (size_t)(t + 1) * kstep;
            const char* a2 = last ? nA : cA + (size_t)(t + 2) * kstep; const char* b2 = last ? nB : cB + (size_t)(t + 2) * kstep;
            const char* a3 = a2 + kstep; const char* b3 = b2 + kstep;
            if (last && has_next) S.a_ready(nxt);
            if constexpr (SP2) {
            PG8_LDB(B0, 0, 0); PG8_LDB(B1, 0, 1); PG8_SCHED; PG8_LDA(At, 0, 0); PG8_STAGE(PG8_SA(1, 1), a1 + hstep, voffA);
            PG8_WAIT_V(8); PG8_WAIT_L(0); PG8_BAR; PG8_MMA(0, 0, At, B0); PG8_MMA(0, 1, At, B1); PG8_BAR; PG8_SCHED;
            PG8_LDA(At, 0, 1); PG8_STAGE(PG8_SB(0, 0), b2, voffB); PG8_STAGE(PG8_SB(0, 1), b2 + hstep, voffB); PG8_STAGE(PG8_SA(0, 0), a2, voffA);
            PG8_WAIT_V(8); PG8_WAIT_L(0); PG8_BAR; PG8_MMA(1, 0, At, B0); PG8_MMA(1, 1, At, B1); PG8_BAR; PG8_SCHED;
            PG8_LDB(B0, 1, 0); PG8_LDB(B1, 1, 1); PG8_SCHED; PG8_LDA(At, 1, 0); PG8_STAGE(PG8_SA(0, 1), a2 + hstep, voffA);
            PG8_WAIT_V(8); PG8_WAIT_L(0); PG8_BAR; PG8_MMA(0, 0, At, B0); PG8_MMA(0, 1, At, B1); PG8_BAR; PG8_SCHED;
            PG8_LDA(At, 1, 1); PG8_STAGE(PG8_SB(1, 0), b3, voffB); PG8_STAGE(PG8_SB(1, 1), b3 + hstep, voffB); PG8_STAGE(PG8_SA(1, 0), a3, voffA);
            PG8_WAIT_V(8); PG8_WAIT_L(0); PG8_BAR; PG8_MMA(1, 0, At, B0); PG8_MMA(1, 1, At, B1); PG8_BAR; PG8_SCHED;
            } else {
            PG8_LDB(B0, 0, 0); PG8_SCHED; PG8_LDA(At, 0, 0); PG8_STAGE(PG8_SA(1, 1), a1 + hstep, voffA);
            PG8_WAIT_L(8); PG8_BAR; PG8_WAIT_L(0); PG8_MMA(0, 0, At, B0); PG8_BAR; PG8_SCHED;
            PG8_LDB(B1, 0, 1); PG8_STAGE(PG8_SB(0, 0), b2, voffB);
            PG8_BAR; PG8_WAIT_L(0); PG8_MMA(0, 1, At, B1); PG8_BAR;
            PG8_LDA(At, 0, 1); PG8_STAGE(PG8_SA(0, 0), a2, voffA);
            PG8_BAR; PG8_WAIT_L(0); PG8_MMA(1, 0, At, B0); PG8_BAR; PG8_SCHED;
            PG8_STAGE(PG8_SB(0, 1), b2 + hstep, voffB);
            PG8_WAIT_V(6); PG8_BAR; PG8_MMA(1, 1, At, B1); PG8_BAR;
            PG8_LDB(B0, 1, 0); PG8_SCHED; PG8_LDA(At, 1, 0); PG8_STAGE(PG8_SA(0, 1), a2 + hstep, voffA);
            PG8_WAIT_L(8); PG8_BAR; PG8_WAIT_L(0); PG8_MMA(0, 0, At, B0); PG8_BAR; PG8_SCHED;
            PG8_LDB(B1, 1, 1); PG8_STAGE(PG8_SB(1, 0), b3, voffB);
            PG8_BAR; PG8_WAIT_L(0); PG8_MMA(0, 1, At, B1); PG8_BAR;
            PG8_LDA(At, 1, 1); PG8_STAGE(PG8_SA(1, 0), a3, voffA);
            PG8_BAR; PG8_WAIT_L(0); PG8_MMA(1, 0, At, B0); PG8_BAR; PG8_SCHED;
            PG8_STAGE(PG8_SB(1, 1), b3 + hstep, voffB);
            PG8_WAIT_V(6); PG8_BAR; PG8_MMA(1, 1, At, B1); PG8_BAR;
            }
        }
        if constexpr (ALIGN_EPI) { if (wr == 0) PG8_BAR; }
        if constexpr (ESZ == 1 && !I8) asm volatile("s_nop 15\n\ts_nop 15" ::: "memory");
        bool restart = true;
        if constexpr (!Epi::AFTER_DRAIN) { restart = E(acc, cur, wr, wc, fr, fq); S.done(cur); }
        if (!has_next) break;
        if (restart) {
#pragma unroll
        for (int a = 0; a < 2; ++a)
#pragma unroll
            for (int b = 0; b < 2; ++b)
#pragma unroll
                for (int m = 0; m < 4; ++m)
#pragma unroll
                    for (int n = 0; n < 2; ++n) acc[a][b][m][n] = (f32x4){0.f, 0.f, 0.f, 0.f};
        }
        cur = nxt; cA = nA; cB = nB; ++ui;
        if constexpr (ALIGN_EPI) { if (wr == 1) PG8_BAR; }
    }
    PG8_WAIT_V(0);
    if constexpr (!ALIGN_EPI) { if (wr == 0) PG8_BAR; }
    PG8_BAR;
#undef PG8_SA
#undef PG8_SB
#undef PG8_STAGE
#undef PG8_LDA
#undef PG8_LDB
#undef PG8_MMA
#undef PG8_WAIT_V
#undef PG8_WAIT_L
#undef PG8_BAR
#undef PG8_SCHED
}
}

__device__ __forceinline__ float sigmoidf_(float v) { return __builtin_amdgcn_rcpf(1.f + __builtin_amdgcn_exp2f(-v * LOG2E)); }
__device__ __forceinline__ u32x4 pack8(const float (&v)[8]) { u32x4 w; w.x = cvtpk(v[0], v[1]); w.y = cvtpk(v[2], v[3]); w.z = cvtpk(v[4], v[5]); w.w = cvtpk(v[6], v[7]); return w; }
__device__ __forceinline__ u32x2 pack8_fp8(const float (&v)[8], float sc) {
    float c[8];
#pragma unroll
    for (int i = 0; i < 8; ++i) c[i] = __builtin_amdgcn_fmed3f(v[i] * sc, -448.f, 448.f);
    int lo = 0, hi = 0;
    lo = __builtin_amdgcn_cvt_pk_fp8_f32(c[0], c[1], lo, false); lo = __builtin_amdgcn_cvt_pk_fp8_f32(c[2], c[3], lo, true);
    hi = __builtin_amdgcn_cvt_pk_fp8_f32(c[4], c[5], hi, false); hi = __builtin_amdgcn_cvt_pk_fp8_f32(c[6], c[7], hi, true);
    u32x2 w; w.x = (unsigned)lo; w.y = (unsigned)hi; return w;
}
__device__ __forceinline__ void unpack8(u32x4 w, float (&v)[8]) { v[0] = bf_lo(w.x); v[1] = bf_hi(w.x); v[2] = bf_lo(w.y); v[3] = bf_hi(w.y); v[4] = bf_lo(w.z); v[5] = bf_hi(w.z); v[6] = bf_lo(w.w); v[7] = bf_hi(w.w); }

struct FIn {
    template <class P_, class TP_> __device__ __forceinline__ void seam_i(int, float (&)[8], const P_&, const TP_&, int) const {}
    static constexpr int SEGS = 1; static constexpr bool PAIRED = true; typedef pg8::NoPre Pre;
    __device__ __forceinline__ void preload(int, int, Pre&) const {} __device__ __forceinline__ void preload_seam(int, int, Pre&) const {} __device__ __forceinline__ void seam(int, int, float (&)[8], const Pre&) const {}
    template <class TP> __device__ __forceinline__ void operator()(int, int, int, float (&)[8], const Pre&, const TP&, int) const {}
    bf16_t *Q, *KV, *PZ, *RG, *SGP; const float* bias; const float* SW; const float* XS0;
    static constexpr bool IACC = true;
    struct TilePre { u32x4 b[2]; f32x4 c[4]; };
    __device__ __forceinline__ float row_scale(int row) const { return XS0[row]; }
    __device__ __forceinline__ void tile_preload(int row0, int col, int pn, TilePre& t) const {
        const float* p0 = (pn < 7) ? bias + col : bias + 1792 + (pn - 7) * 128 + (col & 127);
        const float* p1 = (pn < 7) ? bias + col + 128 : bias + 2816 + (pn - 7) * 128 + (col & 127);
        { const f32x4 a0 = *(const f32x4*)p0, a1 = *(const f32x4*)(p0 + 4), a2 = *(const f32x4*)p1, a3 = *(const f32x4*)(p1 + 4);
          t.b[0].x = cvtpk(a0[0], a0[1]); t.b[0].y = cvtpk(a0[2], a0[3]); t.b[0].z = cvtpk(a1[0], a1[1]); t.b[0].w = cvtpk(a1[2], a1[3]);
          t.b[1].x = cvtpk(a2[0], a2[1]); t.b[1].y = cvtpk(a2[2], a2[3]); t.b[1].z = cvtpk(a3[0], a3[1]); t.b[1].w = cvtpk(a3[2], a3[3]); }
        t.c[0] = *(const f32x4*)(SW + col); t.c[1] = *(const f32x4*)(SW + col + 4); t.c[2] = *(const f32x4*)(SW + col + 128); t.c[3] = *(const f32x4*)(SW + col + 132);
    }
    __device__ __forceinline__ void plain(int row, int col, int pn, float (&v)[8], const u32x4& bb, const f32x4& c0, const f32x4& c1) const {
        float b[8]; unpack8(bb, b);
        v[0] = v[0] * c0[0] + b[0]; v[1] = v[1] * c0[1] + b[1]; v[2] = v[2] * c0[2] + b[2]; v[3] = v[3] * c0[3] + b[3]; v[4] = v[4] * c1[0] + b[4]; v[5] = v[5] * c1[1] + b[5]; v[6] = v[6] * c1[2] + b[6]; v[7] = v[7] * c1[3] + b[7];
        bf16_t* dst;
        if (pn < 4) { dst = Q + (size_t)row * 1024 + col;
#pragma unroll
            for (int i = 0; i < 8; ++i) v[i] *= QSCALE; }
        else if (pn == 4) dst = KV + (size_t)row * 256 + (col - 1024);
        else dst = PZ + (size_t)row * 512 + (col - 1280);
        *(u32x4*)dst = pack8(v);
    }
    __device__ __forceinline__ void pair(int row, int col, int pn, float (&v0)[8], float (&v1)[8], const TilePre& t) const {
        if (pn < 7) { plain(row, col, pn, v0, t.b[0], t.c[0], t.c[1]); plain(row, col + 128, pn, v1, t.b[1], t.c[2], t.c[3]); return; }
        const int ch = (pn - 7) * 128 + (col & 127);
        float ba[8], bp[8]; unpack8(t.b[0], ba); unpack8(t.b[1], bp);
        const float ca[8] = {t.c[0][0], t.c[0][1], t.c[0][2], t.c[0][3], t.c[1][0], t.c[1][1], t.c[1][2], t.c[1][3]}, cp[8] = {t.c[2][0], t.c[2][1], t.c[2][2], t.c[2][3], t.c[3][0], t.c[3][1], t.c[3][2], t.c[3][3]};
        float rr[8]; unsigned kk[8];
#pragma unroll
        for (int i = 0; i < 8; ++i) { const float sgp_ = sigmoidf_(v1[i] * cp[i] + bp[i]), da_ = 1.f + __builtin_amdgcn_exp2f(-(v0[i] * ca[i] + ba[i]) * LOG2E);
            const float kf = fmaxf(__builtin_rintf(sgp_ * 255.f), 1.f); kk[i] = (unsigned)kf; rr[i] = 255.f * __builtin_amdgcn_rcpf(da_ * kf); }
        *(u32x2*)((unsigned char*)RG + (size_t)row * 1024 + ch) = pack8_fp8(rr, 1.f);
        u32x2 kw; kw.x = kk[0] | (kk[1] << 8) | (kk[2] << 16) | (kk[3] << 24); kw.y = kk[4] | (kk[5] << 8) | (kk[6] << 16) | (kk[7] << 24);
        *(u32x2*)((unsigned char*)SGP + (size_t)row * 1024 + ch) = kw;
    }
};
struct FMerge {
    static constexpr int SEGS = 2; static constexpr bool PAIRED = false; template <class TP> __device__ __forceinline__ void pair(int, int, int, float (&)[8], float (&)[8], const TP&) const {}
    static constexpr bool IACC = true;
    struct TilePre { f32x4 c[4]; f32x4 rc[4]; };
    struct Pre { u32x2 a; float r; };
    const bf16_t* RG; const bf16_t* SGP; bf16_t* OUT; const float* SP; const float* SWR; const float* SW1;
    __device__ __forceinline__ void tile_preload(int, int col, int, TilePre& t) const {
#pragma unroll
        for (int h = 0; h < 2; ++h)
#pragma unroll
            for (int q4 = 0; q4 < 2; ++q4) { t.c[h * 2 + q4] = *(const f32x4*)(SW1 + col + h * 128 + q4 * 4); t.rc[h * 2 + q4] = *(const f32x4*)(SWR + col + h * 128 + q4 * 4); }
    }
    __device__ __forceinline__ float row_scale(int row) const { return SP[row]; }
    __device__ __forceinline__ void preload_seam(int row, int col, Pre& p) const { p.a = *(const u32x2*)((const unsigned char*)RG + (size_t)row * 1024 + col); p.r = SP[row]; }
    __device__ __forceinline__ void preload(int row, int col, Pre& p) const { p.a = *(const u32x2*)((const unsigned char*)SGP + (size_t)row * 1024 + col); p.r = 0.f; }
    template <class TP> __device__ __forceinline__ void seam_i(int col, float (&v)[8], const Pre& p, const TP& t, int bj) const {
        const unsigned lo = p.a.x, hi = p.a.y;
        const f32x2_t a0 = __builtin_amdgcn_cvt_pk_f32_fp8((int)lo, false), a1 = __builtin_amdgcn_cvt_pk_f32_fp8((int)lo, true), a2 = __builtin_amdgcn_cvt_pk_f32_fp8((int)hi, false), a3 = __builtin_amdgcn_cvt_pk_f32_fp8((int)hi, true);
        const float R[8] = {a0.x, a0.y, a1.x, a1.y, a2.x, a2.y, a3.x, a3.y};
        const f32x4 r0 = bj ? t.rc[2] : t.rc[0], r1 = bj ? t.rc[3] : t.rc[1];
        const float rc[8] = {r0[0], r0[1], r0[2], r0[3], r1[0], r1[1], r1[2], r1[3]};
        const float ip = __builtin_amdgcn_rcpf(fmaxf(p.r, 1e-30f));
#pragma unroll
        for (int i = 0; i < 8; ++i) v[i] = __int_as_float(__float2int_rn((float)__float_as_int(v[i]) * (R[i] * (rc[i] * ip))));
    }
    __device__ __forceinline__ void seam(int, int, float (&)[8], const Pre&) const {}
    __device__ __forceinline__ void operator()(int row, int col, int, float (&v)[8], const Pre& p, const TilePre& t, int bj) const {
        const unsigned lo = p.a.x, hi = p.a.y;
        const float b[8] = {(float)(lo & 0xffu), (float)((lo >> 8) & 0xffu), (float)((lo >> 16) & 0xffu), (float)(lo >> 24), (float)(hi & 0xffu), (float)((hi >> 8) & 0xffu), (float)((hi >> 16) & 0xffu), (float)(hi >> 24)};
        const f32x4 c0 = bj ? t.c[2] : t.c[0], c1 = bj ? t.c[3] : t.c[1];
        const float cc[8] = {c0[0], c0[1], c0[2], c0[3], c1[0], c1[1], c1[2], c1[3]};
#pragma unroll
        for (int i = 0; i < 8; ++i) v[i] *= b[i] * cc[i] * (1.f / 255.f);
        *(u32x2*)((unsigned char*)OUT + (size_t)row * 1024 + col) = pack8_fp8(v, MRG_SCALE);
    }
};
struct FRes {
    template <class P_, class TP_> __device__ __forceinline__ void seam_i(int, float (&)[8], const P_&, const TP_&, int) const {}
    static constexpr int SEGS = 1; static constexpr bool PAIRED = false; template <class TP> __device__ __forceinline__ void pair(int, int, int, float (&)[8], float (&)[8], const TP&) const {} struct TilePre {}; static constexpr bool IACC = false; __device__ __forceinline__ void tile_preload(int, int, int, TilePre&) const {} __device__ __forceinline__ float row_scale(int) const { return 1.f; }
    struct Pre { u32x2 a; float r; };
    const signed char* XH; const float* IRS; bf16_t* H; const float* XS0;
    __device__ __forceinline__ void preload(int row, int col, Pre& p) const { p.a = *(const u32x2*)(XH + (size_t)row * 1024 + col); p.r = IRS[row] * XS0[row]; }
    __device__ __forceinline__ void preload_seam(int, int, Pre&) const {}
    __device__ __forceinline__ void seam(int, int, float (&)[8], const Pre&) const {}
    __device__ __forceinline__ void operator()(int row, int col, int, float (&v)[8], const Pre& p, const TilePre&, int) const {
        const int lo = (int)p.a.x, hi = (int)p.a.y;
        const float xh[8] = {(float)((lo << 24) >> 24), (float)((lo << 16) >> 24), (float)((lo << 8) >> 24), (float)(lo >> 24), (float)((hi << 24) >> 24), (float)((hi << 16) >> 24), (float)((hi << 8) >> 24), (float)(hi >> 24)};
#pragma unroll
        for (int i = 0; i < 8; ++i) v[i] = v[i] * (1.f / (MRG_SCALE * W8_SCALE)) + xh[i] * p.r;
        *(u32x4*)(H + (size_t)row * 1024 + col) = pack8(v);
    }
};
struct FQP {
    template <class P_, class TP_> __device__ __forceinline__ void seam_i(int, float (&)[8], const P_&, const TP_&, int) const {}
    static constexpr int SEGS = 1; static constexpr bool PAIRED = false; template <class TP> __device__ __forceinline__ void pair(int, int, int, float (&)[8], float (&)[8], const TP&) const {}
    static constexpr bool IACC = true;
    typedef pg8::NoPre Pre;
    unsigned short* OUT; const float* XS; const float* SW;
    struct TilePre { f32x4 c[4]; };
    __device__ __forceinline__ void tile_preload(int, int col, int, TilePre& t) const { t.c[0] = *(const f32x4*)(SW + col); t.c[1] = *(const f32x4*)(SW + col + 4); t.c[2] = *(const f32x4*)(SW + col + 128); t.c[3] = *(const f32x4*)(SW + col + 132); }
    __device__ __forceinline__ float row_scale(int row) const { return XS[row]; }
    __device__ __forceinline__ void preload(int, int, Pre&) const {}
    __device__ __forceinline__ void preload_seam(int, int, Pre&) const {}
    __device__ __forceinline__ void seam(int, int, float (&)[8], const Pre&) const {}
    __device__ __forceinline__ void operator()(int row, int col, int, float (&v)[8], const Pre&, const TilePre& t, int bj) const {
        const int hp = col >> 7, key0 = col & 127, hh = key0 >> 6, c = (key0 & 63) >> 3;
        const f32x4 c0 = bj ? t.c[2] : t.c[0], c1 = bj ? t.c[3] : t.c[1];
        typedef _Float16 h2_t __attribute__((ext_vector_type(2)));
        u32x4 w;
        { const h2_t a = __builtin_convertvector((f32x2_t){v[0] * c0[0], v[1] * c0[1]}, h2_t), b = __builtin_convertvector((f32x2_t){v[2] * c0[2], v[3] * c0[3]}, h2_t), cc = __builtin_convertvector((f32x2_t){v[4] * c1[0], v[5] * c1[1]}, h2_t), d = __builtin_convertvector((f32x2_t){v[6] * c1[2], v[7] * c1[3]}, h2_t);
          w.x = __builtin_bit_cast(unsigned, a); w.y = __builtin_bit_cast(unsigned, b); w.z = __builtin_bit_cast(unsigned, cc); w.w = __builtin_bit_cast(unsigned, d); }
        *(u32x4*)(OUT + ((size_t)((row >> 5) * 16 + hp) * 4096 + (((c * 2 + hh) * 32 + (row & 31)) * 8))) = w;
    }
};
struct FPlain {
    static constexpr int SEGS = 1; static constexpr bool PAIRED = false; template <class TP> __device__ __forceinline__ void pair(int, int, int, float (&)[8], float (&)[8], const TP&) const {} typedef pg8::NoPre Pre; __device__ __forceinline__ void preload(int, int, Pre&) const {} __device__ __forceinline__ void preload_seam(int, int, Pre&) const {} __device__ __forceinline__ void seam(int, int, float (&)[8], const Pre&) const {} struct TilePre {}; static constexpr bool IACC = false; __device__ __forceinline__ void tile_preload(int, int, int, TilePre&) const {} __device__ __forceinline__ float row_scale(int) const { return 1.f; }
    bf16_t* OUT; int ldc;
    __device__ __forceinline__ void operator()(int row, int col, int, float (&v)[8], const Pre&, const TilePre&, int) const { *(u32x4*)(OUT + (size_t)row * ldc + col) = pack8(v); }
};

__device__ __forceinline__ int gate_src_col(int n) { if (n < 1792) return n; const int o = n - 1792, t = o >> 8, h = (o >> 7) & 1, i = o & 127; return (h ? 2816 : 1792) + 128 * t + i; }
__device__ __forceinline__ void p0_transpose_item(const float* W, int K, int N, bf16_t* WT, LAS float* scr, int item, int lane, int ldk = 0, const float* kgain = nullptr, bool nperm = false, float f8scale = 0.f) {
    if (ldk == 0) ldk = K;
    const int nblk = N / 32, kb = item / nblk, nb = item % nblk, k0 = 64 * kb, n0 = 32 * nb, ns = nperm ? gate_src_col(n0) : n0;
#pragma unroll 8
    for (int i = 0; i < 32; ++i) { const int kk = 2 * i + (lane >> 5); scr[kk * 33 + (lane & 31)] = W[(size_t)(k0 + kk) * N + ns + (lane & 31)] * (kgain ? kgain[k0 + kk] : 1.f); }
    asm volatile("s_waitcnt lgkmcnt(0)" ::: "memory");
    const int c = lane & 7;
#pragma unroll
    for (int j = 0; j < 4; ++j) { const int n = (lane >> 3) + 8 * j; const LAS float* s = scr + (8 * c) * 33 + n;
        if (f8scale != 0.f) { const float v8[8] = {s[0 * 33], s[1 * 33], s[2 * 33], s[3 * 33], s[4 * 33], s[5 * 33], s[6 * 33], s[7 * 33]};
            *(u32x2*)((unsigned char*)WT + (size_t)(n0 + n) * ldk + k0 + 8 * c) = pack8_fp8(v8, f8scale); continue; }
        u32x4 o; o.x = cvtpk(s[0 * 33], s[1 * 33]); o.y = cvtpk(s[2 * 33], s[3 * 33]); o.z = cvtpk(s[4 * 33], s[5 * 33]); o.w = cvtpk(s[6 * 33], s[7 * 33]);
        *(u32x4*)(WT + (size_t)(n0 + n) * ldk + k0 + 8 * c) = o; }
    asm volatile("s_waitcnt lgkmcnt(0)" ::: "memory");
}
template <int R, class SRC> __device__ __forceinline__ void rms_rows_to_bf16(const SRC* xrow, size_t rstride, const float* gain, bf16_t* orow, int lane, signed char* x8 = nullptr, float* xs = nullptr, size_t sstride = 0, float* irs = nullptr, bool irs_rms = false) {
    f32x4 v[R][4];
#pragma unroll
    for (int r = 0; r < R; ++r)
#pragma unroll
        for (int j = 0; j < 4; ++j) {
            if constexpr (sizeof(SRC) == 4) v[r][j] = *((const f32x4*)(xrow + r * rstride) + lane + 64 * j);
            else { const u32x2 w = *((const u32x2*)(xrow + r * rstride) + lane + 64 * j); v[r][j] = (f32x4){bf_lo(w.x), bf_hi(w.x), bf_lo(w.y), bf_hi(w.y)}; } }
    f32x4 gg[4];
#pragma unroll
    for (int j = 0; j < 4; ++j) gg[j] = gain ? *((const f32x4*)gain + lane + 64 * j) : (f32x4){1.f, 1.f, 1.f, 1.f};
#pragma unroll
    for (int r = 0; r < R; ++r) {
        float s = 0.f;
#pragma unroll
        for (int j = 0; j < 4; ++j) s += (v[r][j].x * v[r][j].x + v[r][j].y * v[r][j].y) + (v[r][j].z * v[r][j].z + v[r][j].w * v[r][j].w);
        const float rms = sqrtf(wave_sum(s) * (1.f / D) + EPS), rstd = 1.f / rms;
        if (irs && lane == 0) irs[r * sstride] = (orow || irs_rms) ? rms : rstd;
        u32x2* o8 = (u32x2*)(orow + r * rstride) + lane;
        float m = 0.f;
#pragma unroll
        for (int j = 0; j < 4; ++j) { v[r][j] = (f32x4){v[r][j].x * rstd * gg[j].x, v[r][j].y * rstd * gg[j].y, v[r][j].z * rstd * gg[j].z, v[r][j].w * rstd * gg[j].w};
            if (orow) { u32x2 w; w.x = cvtpk(v[r][j].x, v[r][j].y); w.y = cvtpk(v[r][j].z, v[r][j].w); o8[64 * j] = w; }
            m = fmaxf(fmaxf(m, fmaxf(fabsf(v[r][j].x), fabsf(v[r][j].y))), fmaxf(fabsf(v[r][j].z), fabsf(v[r][j].w))); }
        if (x8) {
#pragma unroll
            for (int o = 1; o < 64; o <<= 1) m = fmaxf(m, __shfl_xor(m, o));
            constexpr float QM = sizeof(SRC) == 4 ? 127.f : 119.f;
            const float sc = m > 0.f ? QM / m : 1.f;
#pragma unroll
            for (int j = 0; j < 4; ++j) { const int q0 = __float2int_rn(v[r][j].x * sc), q1 = __float2int_rn(v[r][j].y * sc), q2 = __float2int_rn(v[r][j].z * sc), q3 = __float2int_rn(v[r][j].w * sc);
                *((unsigned*)(x8 + r * rstride) + lane + 64 * j) = (unsigned)((q0 & 0xff) | ((q1 & 0xff) << 8) | ((q2 & 0xff) << 16) | (q3 << 24)); }
            if (lane == 0) xs[r * sstride] = m > 0.f ? m / QM : 1.f;
        }
    }
}
__device__ __forceinline__ float quant_row_i8(const bf16_t* wrow, signed char* orow, float* sc_out, int lane) {
    const u32x4 wa = ((const u32x4*)wrow)[lane], wb = ((const u32x4*)wrow)[64 + lane];
    float va[8], vb[8]; unpack8(wa, va); unpack8(wb, vb);
    float m = 0.f;
#pragma unroll
    for (int i = 0; i < 8; ++i) m = fmaxf(m, fmaxf(fabsf(va[i]), fabsf(vb[i])));
#pragma unroll
    for (int o = 1; o < 64; o <<= 1) m = fmaxf(m, __shfl_xor(m, o));
    const float sc = m > 0.f ? 127.f / m : 0.f;
    int qa[8], qb[8];
#pragma unroll
    for (int i = 0; i < 8; ++i) { qa[i] = __float2int_rn(va[i] * sc) & 0xff; qb[i] = __float2int_rn(vb[i] * sc) & 0xff; }
    u32x2 oa, ob; oa.x = qa[0] | (qa[1] << 8) | (qa[2] << 16) | (qa[3] << 24); oa.y = qa[4] | (qa[5] << 8) | (qa[6] << 16) | (qa[7] << 24);
    ob.x = qb[0] | (qb[1] << 8) | (qb[2] << 16) | (qb[3] << 24); ob.y = qb[4] | (qb[5] << 8) | (qb[6] << 16) | (qb[7] << 24);
    *(u32x2*)(orow + lane * 8) = oa; *(u32x2*)(orow + 512 + lane * 8) = ob;
    if (lane == 0) *sc_out = m * (1.f / 127.f);
    return m * (1.f / 127.f);
}
__device__ __forceinline__ float quant_row512_i8(const bf16_t* wrow, signed char* orow, float* sc_out, int lane) {
    const u32x4 wa = ((const u32x4*)wrow)[lane];
    float va[8]; unpack8(wa, va);
    float m = 0.f;
#pragma unroll
    for (int i = 0; i < 8; ++i) m = fmaxf(m, fabsf(va[i]));
    m = wave_max(m);
    const float sc = m > 0.f ? 127.f / m : 0.f;
    unsigned qa[8];
#pragma unroll
    for (int i = 0; i < 8; ++i) qa[i] = (unsigned)__float2int_rn(va[i] * sc) & 0xffu;
    u32x2 oa; oa.x = qa[0] | (qa[1] << 8) | (qa[2] << 16) | (qa[3] << 24); oa.y = qa[4] | (qa[5] << 8) | (qa[6] << 16) | (qa[7] << 24);
    *(u32x2*)(orow + lane * 8) = oa;
    if (lane == 0) *sc_out = m * (1.f / 127.f);
    return m * (1.f / 127.f);
}
template <int R, bool I8> __device__ __forceinline__ void fp8_rows(const float* const (&src)[R], unsigned char* const (&dst)[R], float* const (&inv)[R], int lane, const int (&i4)[R]) {
    f32x4 v[R][4];
#pragma unroll
    for (int r = 0; r < R; ++r)
#pragma unroll
        for (int j = 0; j < 4; ++j) v[r][j] = *((const f32x4*)src[r] + lane + 64 * j);
#pragma unroll
    for (int r = 0; r < R; ++r) {
        float m = 0.f;
#pragma unroll
        for (int j = 0; j < 4; ++j) m = fmaxf(fmaxf(m, fmaxf(fabsf(v[r][j].x), fabsf(v[r][j].y))), fmaxf(fabsf(v[r][j].z), fabsf(v[r][j].w)));
#pragma unroll
        for (int o = 1; o < 64; o <<= 1) m = fmaxf(m, __shfl_xor(m, o));
        const float qmax = I8 ? 127.f : 448.f;
        float sc = m > 0.f ? qmax / m : 1.f, dq = m > 0.f ? m / qmax : 1.f;
        if (I8 && i4[r]) {
            float s2 = 0.f;
#pragma unroll
            for (int j = 0; j < 4; ++j) s2 += (v[r][j].x * v[r][j].x + v[r][j].y * v[r][j].y) + (v[r][j].z * v[r][j].z + v[r][j].w * v[r][j].w);
#pragma unroll
            for (int o = 1; o < 64; o <<= 1) s2 += __shfl_xor(s2, o);
            dq = fmaxf(0.34f * sqrtf(s2 * (1.f / 1024.f)), m * (1.f / 14.f)); if (!(dq > 0.f)) dq = 1.f;
            sc = 1.f / dq; }
#pragma unroll
        for (int j = 0; j < 4; ++j) { int w = 0;
            if (I8 && i4[r]) {
                const int q0 = __float2int_rn(__builtin_amdgcn_fmed3f(v[r][j].x * sc, -8.f, 7.f)), q1 = __float2int_rn(__builtin_amdgcn_fmed3f(v[r][j].y * sc, -8.f, 7.f)),
                          q2 = __float2int_rn(__builtin_amdgcn_fmed3f(v[r][j].z * sc, -8.f, 7.f)), q3 = __float2int_rn(__builtin_amdgcn_fmed3f(v[r][j].w * sc, -8.f, 7.f));
                const int lb = (i4[r] == 2) ? 8 : 0;
                if (lane < 32) w = ((q0 + lb) & 15) | (((q1 + lb) & 15) << 8) | (((q2 + lb) & 15) << 16) | (((q3 + lb) & 15) << 24);
                else w = ((q0 & 15) << 4) | ((q1 & 15) << 12) | ((q2 & 15) << 20) | ((q3 & 15) << 28);
                w |= __shfl_xor(w, 32);
                if (lane < 32) *((unsigned*)(dst[r] + (size_t)j * (NEXP * 128)) + lane) = (unsigned)w;
                continue; }
            if (I8) { const int q0 = __float2int_rn(v[r][j].x * sc), q1 = __float2int_rn(v[r][j].y * sc), q2 = __float2int_rn(v[r][j].z * sc), q3 = __float2int_rn(v[r][j].w * sc);
                w = (q0 & 0xff) | ((q1 & 0xff) << 8) | ((q2 & 0xff) << 16) | (q3 << 24); }
            else { w = __builtin_amdgcn_cvt_pk_fp8_f32(v[r][j].x * sc, v[r][j].y * sc, w, false); w = __builtin_amdgcn_cvt_pk_fp8_f32(v[r][j].z * sc, v[r][j].w * sc, w, true); }
            *((unsigned*)(dst[r] + (size_t)(2 * j + (lane >> 5)) * (NEXP * 128)) + (lane & 31)) = (unsigned)w; }
        if (lane == 0) *inv[r] = dq;
    }
}
__device__ __forceinline__ float reduce16(float (&v)[16], int lane) {
#pragma unroll
    for (int i = 0; i < 8; ++i) { const bool up = (lane & 32) != 0; const float send = up ? v[i] : v[i + 8], keep = up ? v[i + 8] : v[i]; v[i] = keep + __shfl_xor(send, 32); }
#pragma unroll
    for (int i = 0; i < 4; ++i) { const bool up = (lane & 16) != 0; const float send = up ? v[i] : v[i + 4], keep = up ? v[i + 4] : v[i]; v[i] = keep + __shfl_xor(send, 16); }
#pragma unroll
    for (int i = 0; i < 2; ++i) { const bool up = (lane & 8) != 0; const float send = up ? v[i] : v[i + 2], keep = up ? v[i + 2] : v[i]; v[i] = keep + __shfl_xor(send, 8); }
    { const bool up = (lane & 4) != 0; const float send = up ? v[0] : v[1], keep = up ? v[1] : v[0]; v[0] = keep + __shfl_xor(send, 4); }
    float r = v[0]; r += __shfl_xor(r, 2); r += __shfl_xor(r, 1); return r;
}

namespace att {
constexpr int KSTR = 144, VSTR = 392, NSLOT = 6, K_OFF = 0, V_OFF = NSLOT * 32 * KSTR;
__device__ __forceinline__ int crow(int r, int hi) { return (r & 3) + 8 * (r >> 2) + 4 * hi; }
__device__ __forceinline__ void run(LAS unsigned char* lds, const bf16_t* Q, const bf16_t* KV, bf16_t* O, int ostride, const float* sinks, int b, int kvh, int rn) {
    const int tid = threadIdx.x, lane = tid & 63, wid = __builtin_amdgcn_readfirstlane(tid >> 6);
    const int r0 = rn * 512; const long rowbase = (long)b * SEQ;
    const int q = lane & 31, hi = lane >> 5, hq = kvh * 8 + wid;
    const int kfirst = (r0 == 0) ? 4 : 0;
    const int sx = tid & 255, skey = sx >> 3, spart = sx & 7; const bool isv = tid >= 256;
    const bf16_t* sbase = KV + (rowbase + r0 - 128 + skey) * 256 + (isv ? 128 : 0) + kvh * 64 + spart * 8;
#define ATT_WRITE(val, slot) do { if (!isv) *(LAS u32x4*)(lds + K_OFF + ((slot) * 32 + skey) * KSTR + spart * 16) = (val); else { \
        LAS unsigned short* vt_ = (LAS unsigned short*)(lds + V_OFF + (spart * 8) * VSTR + ((slot) * 32 + skey) * 2); \
        vt_[0 * (VSTR / 2)] = (unsigned short)((val).x & 0xffffu); vt_[1 * (VSTR / 2)] = (unsigned short)((val).x >> 16); vt_[2 * (VSTR / 2)] = (unsigned short)((val).y & 0xffffu); vt_[3 * (VSTR / 2)] = (unsigned short)((val).y >> 16); \
        vt_[4 * (VSTR / 2)] = (unsigned short)((val).z & 0xffffu); vt_[5 * (VSTR / 2)] = (unsigned short)((val).z >> 16); vt_[6 * (VSTR / 2)] = (unsigned short)((val).w & 0xffffu); vt_[7 * (VSTR / 2)] = (unsigned short)((val).w >> 16); } } while (0)
    { u32x4 pv[5];
#pragma unroll
      for (int k = 0; k < 5; ++k) pv[k] = *(const u32x4*)(sbase + (size_t)(k >= kfirst ? k : 4) * 32 * 256);
#pragma unroll
      for (int k = 0; k < 5; ++k) if (k >= kfirst) ATT_WRITE(pv[k], k); }
    const float sink2 = sinks[hq] * LOG2E;
    bf16x8 qf[4];
#pragma unroll
    for (int s = 0; s < 4; ++s) qf[s] = *(const bf16x8*)(Q + (rowbase + r0 + q) * 1024 + hq * 64 + s * 16 + hi * 8);
    __syncthreads();
    for (int i = 0; i < 16; ++i) {
        const int q0 = r0 + i * 32;
        const int jstart = (kfirst > i) ? kfirst - i : 0;
        u32x4 stg = (u32x4){0u, 0u, 0u, 0u};
        if (i < 15) stg = *(const u32x4*)(sbase + (size_t)(i + 5) * 32 * 256);
        bf16x8 qn[4];
        { const int inx = (i < 15) ? i + 1 : i;
#pragma unroll
          for (int s = 0; s < 4; ++s) qn[s] = *(const bf16x8*)(Q + (rowbase + r0 + inx * 32 + q) * 1024 + hq * 64 + s * 16 + hi * 8); }
        f32x16 p[5];
#pragma unroll
        for (int j = 0; j < 5; ++j) {
            p[j] = (f32x16){0.f, 0.f, 0.f, 0.f, 0.f, 0.f, 0.f, 0.f, 0.f, 0.f, 0.f, 0.f, 0.f, 0.f, 0.f, 0.f};
            if (j >= jstart) { const int slot = (i + j) % NSLOT;
#pragma unroll
                for (int s = 0; s < 4; ++s) { const bf16x8 kf = *(const LAS bf16x8*)(lds + K_OFF + (slot * 32 + q) * KSTR + (16 * s + 8 * hi) * 2);
                    p[j] = __builtin_amdgcn_mfma_f32_32x32x16_bf16(kf, qf[s], p[j], 0, 0, 0); }
            }
        }
        const float NEG = -1e30f;
        float mx = sink2;
#pragma unroll
        for (int j = 0; j < 5; ++j)
#pragma unroll
            for (int r = 0; r < 16; ++r) { const int cr = crow(r, hi);
                const bool ok = (j >= jstart) && ((j == 0) ? (q < cr) : (j == 4) ? (cr <= q) : true);
                const float sv = ok ? p[j][r] : NEG; p[j][r] = sv; mx = fmaxf(mx, sv); }
        mx = fmaxf(mx, __shfl_xor(mx, 32));
        float l = 0.f;
#pragma unroll
        for (int j = 0; j < 5; ++j)
#pragma unroll
            for (int r = 0; r < 16; ++r) { const float e = __builtin_amdgcn_exp2f(p[j][r] - mx); p[j][r] = e; l += e; }
        l += __shfl_xor(l, 32); l += __builtin_amdgcn_exp2f(sink2 - mx);
        f32x16 o[2];
        o[0] = (f32x16){0.f, 0.f, 0.f, 0.f, 0.f, 0.f, 0.f, 0.f, 0.f, 0.f, 0.f, 0.f, 0.f, 0.f, 0.f, 0.f}; o[1] = o[0];
#pragma unroll
        for (int j = 0; j < 5; ++j) {
            if (j >= jstart) { const int slot = (i + j) % NSLOT;
#pragma unroll
                for (int s2 = 0; s2 < 2; ++s2) {
                    u32x4 pw; pw.x = cvtpk(p[j][8 * s2 + 0], p[j][8 * s2 + 1]); pw.y = cvtpk(p[j][8 * s2 + 2], p[j][8 * s2 + 3]); pw.z = cvtpk(p[j][8 * s2 + 4], p[j][8 * s2 + 5]); pw.w = cvtpk(p[j][8 * s2 + 6], p[j][8 * s2 + 7]);
                    const bf16x8 pf = __builtin_bit_cast(bf16x8, pw);
#pragma unroll
                    for (int db = 0; db < 2; ++db) {
                        const LAS unsigned char* vp = lds + V_OFF + (32 * db + q) * VSTR + (slot * 32 + 16 * s2 + 4 * hi) * 2;
                        const u32x2 lo = *(const LAS u32x2*)vp, hh = *(const LAS u32x2*)(vp + 16);
                        u32x4 vw; vw.x = lo.x; vw.y = lo.y; vw.z = hh.x; vw.w = hh.y;
                        o[db] = __builtin_amdgcn_mfma_f32_32x32x16_bf16(__builtin_bit_cast(bf16x8, vw), pf, o[db], 0, 0, 0);
                    }
                }
            }
        }
        const float inv = 1.f / l;
        unsigned char* orow = (unsigned char*)O + (size_t)(rowbase + q0 + q) * ostride + hq * 64;
        const float invs = inv * (127.f / AO_CLIP);
#pragma unroll
        for (int db = 0; db < 2; ++db)
#pragma unroll
            for (int g4 = 0; g4 < 4; ++g4) { unsigned w = 0;
#pragma unroll
                for (int e = 0; e < 4; ++e) w |= ((unsigned)__float2int_rn(__builtin_amdgcn_fmed3f(o[db][4 * g4 + e] * invs, -127.f, 127.f)) & 0xffu) << (8 * e);
                *(unsigned*)(orow + 32 * db + 8 * g4 + 4 * hi) = w; }
        if (i < 15) { const int slot = (i + 5) % NSLOT; ATT_WRITE(stg, slot); }
#pragma unroll
        for (int s = 0; s < 4; ++s) qf[s] = qn[s];
        __syncthreads();
    }
#undef ATT_WRITE
}
}

__device__ __forceinline__ float gelu_erf(float v) {
    const float av = fabsf(v), t = __builtin_amdgcn_rcpf(av * 0.2316418882f + 1.0f);
    float q = t * 0.5307027145f + (-0.7265760135f); q = q * t + 0.7107068705f; q = q * t + (-0.142248368f); q = q * t + 0.127414796f; q = q * t;
    const float e = __builtin_amdgcn_exp2f((v * v) * (-0.72134752044f));
    const float m = v * (q * e);
    return v < 0.f ? m : v - m;
}

namespace tk {
__device__ __forceinline__ void ce(unsigned& a, unsigned& b) { const unsigned mx = a > b ? a : b, mn = a > b ? b : a; a = mx; b = mn; }
__device__ __forceinline__ void sort16(unsigned (&v)[16]) {
    constexpr int NET[60][2] = {{0,13},{1,12},{2,15},{3,14},{4,8},{5,6},{7,11},{9,10}, {0,5},{1,7},{2,9},{3,4},{6,13},{8,14},{10,15},{11,12}, {0,1},{2,3},{4,5},{6,8},{7,9},{10,11},{12,13},{14,15},
        {0,2},{1,3},{4,10},{5,11},{6,7},{8,9},{12,14},{13,15}, {1,2},{3,12},{4,6},{5,7},{8,10},{9,11},{13,14}, {1,4},{2,6},{5,8},{7,10},{9,13},{11,14}, {2,4},{3,6},{9,12},{11,13}, {3,5},{6,8},{7,9},{10,12},
        {3,4},{5,6},{7,8},{9,10},{11,12}, {6,7},{8,9}};
#pragma unroll
    for (int i = 0; i < 60; ++i) ce(v[NET[i][0]], v[NET[i][1]]);
}
__device__ __forceinline__ void merge16(unsigned (&r)[16], const unsigned (&n)[16]) {
#pragma unroll
    for (int i = 0; i < 16; ++i) r[i] = r[i] > n[15 - i] ? r[i] : n[15 - i];
#pragma unroll
    for (int j = 8; j > 0; j >>= 1)
#pragma unroll
        for (int i = 0; i < 16; ++i) if ((i & j) == 0) ce(r[i], r[i + j]);
}
__device__ __forceinline__ void merge16_xlane(unsigned (&r)[16]) {
    unsigned n[16];
#pragma unroll
    for (int i = 0; i < 16; ++i) n[i] = (unsigned)__shfl_xor((int)r[i], 32);
    merge16(r, n);
}
typedef short s16x2_t __attribute__((ext_vector_type(2)));
__device__ __forceinline__ unsigned okey16x2(unsigned w) { const s16x2_t sg = __builtin_bit_cast(s16x2_t, w) >> 15; return w ^ (__builtin_bit_cast(unsigned, sg) | 0x80008000u); }
__device__ __forceinline__ float ofloat16(unsigned k) { const unsigned x = k >> 16; const unsigned h = (x & 0x8000u) ? (x ^ 0x8000u) : (~x & 0xffffu); return (float)__builtin_bit_cast(_Float16, (unsigned short)h); }
__device__ __forceinline__ unsigned okey(float f) { const unsigned u = __float_as_uint(f); return u ^ ((unsigned)((int)u >> 31) | 0x80000000u); }
__device__ __forceinline__ float ofloat(unsigned k) { return __uint_as_float(k ^ (~(unsigned)((int)k >> 31) | 0x80000000u)); }
}

#define XB_TMO      128
#define XB_XCNT(j)  (256  + 64 * (j))
#define XB_XSUB(j)  (1280 + 64 * (j))
#define XB_XGEN(j)  (2304 + 64 * (j))
#define XB_TOP      3328
#define XB_TOPGEN   3392
#define XCD_BAR_WORDS 3456
#define XB_SPIN_CAP (1u << 18)
__device__ __forceinline__ unsigned xb_ld(unsigned* p)              { return __hip_atomic_load(p, __ATOMIC_RELAXED, __HIP_MEMORY_SCOPE_AGENT); }
__device__ __forceinline__ unsigned xb_add(unsigned* p, unsigned v) { return __hip_atomic_fetch_add(p, v, __ATOMIC_RELAXED, __HIP_MEMORY_SCOPE_AGENT); }
__device__ __forceinline__ unsigned xb_xcc_id() { return (unsigned)__builtin_amdgcn_s_getreg((3 << 11) | 20) & 0xFu; }
#define XB_SPIN(cond, bar) do { unsigned _sp = 0; while (cond) { __builtin_amdgcn_s_sleep(1); \
    if ((++_sp & 255u) == 0u) { if (xb_ld(&(bar)[XB_TMO])) break; if (_sp > XB_SPIN_CAP) { atomicAdd(&(bar)[XB_TMO], 1u); break; } } } } while (0)
struct XcdBarrier { unsigned* bar; unsigned x; volatile LAS unsigned* st; };
__device__ __forceinline__ XcdBarrier xcd_barrier_post(unsigned* bar, volatile LAS unsigned* st) {
    XcdBarrier b; b.bar = bar; b.x = xb_xcc_id(); b.st = st;
    if (threadIdx.x == 0) (void)xb_add(&bar[XB_XCNT(b.x)], 1u);
    return b;
}
__device__ __forceinline__ void xcd_barrier_complete(unsigned* bar, unsigned x, unsigned& nloc, unsigned& nx, unsigned& xmask) {
    const unsigned G = gridDim.x * gridDim.y * gridDim.z;
    unsigned sum, cnt, mine, msk, sp = 0u;
    for (;;) {
        sum = 0u; cnt = 0u; mine = 0u; msk = 0u;
#pragma unroll
        for (unsigned j = 0; j < 16; ++j) { const unsigned c = xb_ld(&bar[XB_XCNT(j)]); sum += c; cnt += (c > 0u) ? 1u : 0u; msk |= (c > 0u) ? (1u << j) : 0u; mine = (j == x) ? c : mine; }
        if (sum == G) break;
        __builtin_amdgcn_s_sleep(1);
        if ((++sp & 255u) == 0u) { if (xb_ld(&bar[XB_TMO])) break; if (sp > XB_SPIN_CAP) { atomicAdd(&bar[XB_TMO], 1u); break; } }
    }
    nloc = mine > 0u ? mine : 1u; nx = cnt > 0u ? cnt : 1u; xmask = msk | (1u << x);
}
__device__ __forceinline__ void xcd_barrier(const XcdBarrier& b) {
    asm volatile("s_waitcnt vmcnt(0)" ::: "memory");
    __syncthreads();
    if (threadIdx.x == 0) {
        unsigned* bar = b.bar;
        __builtin_amdgcn_s_waitcnt(0);
        unsigned nloc = b.st[0], nx = b.st[1], xmask = b.st[2];
        if (nloc == 0u) { xcd_barrier_complete(bar, b.x, nloc, nx, xmask); b.st[0] = nloc; b.st[1] = nx; b.st[2] = xmask; }
        const unsigned old = xb_add(&bar[XB_XSUB(b.x)], 1u);
        const unsigned gen = old / nloc;
        if (old + 1u == (gen + 1u) * nloc) {
            __builtin_amdgcn_fence(__ATOMIC_RELEASE, "agent");
            asm volatile("s_waitcnt vmcnt(0)" ::: "memory");
            const unsigned og = xb_add(&bar[XB_TOP], 1u);
            const unsigned tg = og / nx;
            if (og + 1u == (tg + 1u) * nx) {
#pragma unroll
                for (unsigned j = 0; j < 16; ++j) if ((xmask >> j) & 1u) (void)xb_add(&bar[XB_XGEN(j)], 1u);
            } else XB_SPIN(xb_ld(&bar[XB_XGEN(b.x)]) == gen, bar);
            __builtin_amdgcn_fence(__ATOMIC_ACQUIRE, "agent");
            asm volatile("s_waitcnt vmcnt(0)" ::: "memory");
        } else {
            XB_SPIN(xb_ld(&bar[XB_XGEN(b.x)]) == gen, bar);
            __builtin_amdgcn_fence(__ATOMIC_ACQUIRE, "agent");
            asm volatile("s_waitcnt vmcnt(0)" ::: "memory");
        }
    }
    __syncthreads();
}

#define PROBE_PHASE_A (-1)
#define PROBE_GEMM (-1)
#define PROBE_PHASE_B (-1)
#define PROBE_COUNT 1
#define USE_CG_SEAM0 0
#define PROBE_ATT 1
struct Args { const float* in[16]; float* out; unsigned char* ws; int ph_lo, ph_hi; };

__global__ void __launch_bounds__(512, 2) fwd(Args args) {
    extern __shared__ __attribute__((aligned(16))) unsigned char lds_raw[];
    LAS unsigned char* lds = (LAS unsigned char*)lds_raw;
    cg::grid_group grid = cg::this_grid();
    const int tid = threadIdx.x, lane = tid & 63, wave = __builtin_amdgcn_readfirstlane(tid >> 6);
    const int G = gridDim.x, bx = blockIdx.x;
    const int vcu = (G % 8 == 0) ? (bx % 8) * (G / 8) + bx / 8 : bx;
    const int gw = vcu * 8 + wave, NGW = G * 8;
    const int gt = vcu * 512 + tid, NGT = G * 512;
    unsigned char* ws = args.ws;
    const float* x = args.in[0]; const float* ln_mix_g = args.in[1]; const float* w_in = args.in[2]; const float* b_in = args.in[3];
    const float* sinks = args.in[4]; const float* w_attn_up = args.in[5]; const float* w_pool_grp = args.in[6]; const float* pool_scale = args.in[7];
    const float* w_pool_up = args.in[8]; const float* w_o = args.in[9]; const float* ln_ffn_g = args.in[10]; const float* w_query = args.in[11];
    const float* sub_keys = args.in[12]; const float* u_exp = args.in[13]; const float* v_exp = args.in[14]; const float* ln_final_g = args.in[15];
    float* out = args.out;
    bf16_t* WIN = (bf16_t*)(ws + WS_WIN); bf16_t* WUP = (bf16_t*)(ws + WS_WUP); bf16_t* WPU = (bf16_t*)(ws + WS_WPU); bf16_t* WO = (bf16_t*)(ws + WS_WO);
    bf16_t* WQC = (bf16_t*)(ws + WS_WQC); unsigned char* UT = ws + WS_U; unsigned char* VT = ws + WS_V;
    float* SCU = (float*)(ws + WS_SCU); float* SCV = (float*)(ws + WS_SCV); bf16_t* H = (bf16_t*)(ws + WS_H);
    bf16_t* XN = (bf16_t*)(ws + WS_XN); bf16_t* QB = (bf16_t*)(ws + WS_X8);   bf16_t* AOP = (bf16_t*)(ws + WS_Q);   bf16_t* KVB = (bf16_t*)(ws + WS_KV);
    bf16_t* PZ = (bf16_t*)(ws + WS_PZ); bf16_t* PL = (bf16_t*)(ws + WS_PL); bf16_t* SGA = (bf16_t*)(ws + WS_SGA); bf16_t* SGP = (bf16_t*)(ws + WS_SGP);
    bf16_t* MRG = QB;   float* IRS = (float*)(ws + WS_XS + 524288); float* RS2 = (float*)(ws + WS_XS + 1048576); bf16_t* QP = (bf16_t*)(ws + WS_Q); unsigned short* EID = (unsigned short*)(ws + WS_EID); bf16_t* GSM = (bf16_t*)(ws + WS_GSM); signed char* XH8 = (signed char*)(ws + WS_XH8); float* XS0 = (float*)(ws + WS_XS0); signed char* WC8 = (signed char*)(ws + WS_WC8); float* SWC0 = (float*)(ws + WS_SWC); float* SWC1 = SWC0 + 1024; float* SWCR = SWC0 + 2048; float* SPL = (float*)(ws + WS_SPL); signed char* WQ8 = (signed char*)(ws + WS_WQ8); float* SWQ = (float*)(ws + WS_SWQ); signed char* WIN8 = (signed char*)(ws + WS_WIN8); float* SWIN = (float*)(ws + WS_SWIN); signed char* GS8 = (signed char*)(ws + WS_GS8); float* WSC = (float*)(ws + WS_WSC); float* WSB = (float*)(ws + WS_WSC + 1048576); unsigned short* PART = (unsigned short*)(ws + WS_Q);     signed char* X8 = (signed char*)(ws + WS_X8); float* XS = (float*)(ws + WS_XS); float* SS = (float*)(ws + WS_CTL + 262144); unsigned* CNT = (unsigned*)(ws + WS_CTL + 786432);
    const int lo = args.ph_lo, hi = args.ph_hi;
    volatile LAS unsigned* MISC = (volatile LAS unsigned*)(lds + 155648);
    if (tid < 4) MISC[tid] = 0u;
    __syncthreads();
    XcdBarrier xbar = xcd_barrier_post((unsigned*)(ws + WS_CTL), MISC);
#define IN(k) (lo <= (k) && (k) < hi)
#define GREP(k) (((k) == PROBE_GEMM) ? PROBE_COUNT : 1)
#define PH(k) for (int rep_ = 0; rep_ < (((k) == PROBE_PHASE_A || (k) == PROBE_PHASE_B) ? PROBE_COUNT : 1); ++rep_, (rep_ < (((k) == PROBE_PHASE_A || (k) == PROBE_PHASE_B) ? PROBE_COUNT : 1) ? grid.sync() : (void)0))
#define SEAM(k) do { if (IN(k) && IN((k) + 1)) { if (USE_CG_SEAM0 && (k) == 0) grid.sync(); else xcd_barrier(xbar); } } while (0)

    PH(0) if (IN(0)) {
        for (int step = 0; step < 2; ++step) {
            const bool prep = (step == 0) == (wave < 4);
            if (prep) {
                for (int wt = gw; wt < 2048; wt += NGW) {
                    const int hp = wt >> 7, mt = (wt >> 5) & 3, ntile = wt & 31, r32 = lane & 31, hi2 = lane >> 5;
                    const float* ap = sub_keys + (size_t)(hp * 128 + mt * 32 + r32) * 128 + hi2 * 8;
                    const float* bp = w_query + (size_t)(ntile * 32 + r32) * 2048 + hp * 128 + hi2 * 8;
                    const float g2k = 1.f;
                    f32x16 cacc = (f32x16){0.f, 0.f, 0.f, 0.f, 0.f, 0.f, 0.f, 0.f, 0.f, 0.f, 0.f, 0.f, 0.f, 0.f, 0.f, 0.f};
        #pragma unroll
                    for (int s2 = 0; s2 < 8; ++s2) {
                        const f32x4 a0 = *(const f32x4*)(ap + s2 * 16), a1 = *(const f32x4*)(ap + s2 * 16 + 4), b0 = *(const f32x4*)(bp + s2 * 16), b1 = *(const f32x4*)(bp + s2 * 16 + 4);
                        u32x4 aw, bw; aw.x = cvtpk(a0.x, a0.y); aw.y = cvtpk(a0.z, a0.w); aw.z = cvtpk(a1.x, a1.y); aw.w = cvtpk(a1.z, a1.w);
                        bw.x = cvtpk(b0.x * g2k, b0.y * g2k); bw.y = cvtpk(b0.z * g2k, b0.w * g2k); bw.z = cvtpk(b1.x * g2k, b1.y * g2k); bw.w = cvtpk(b1.z * g2k, b1.w * g2k);
                        cacc = __builtin_amdgcn_mfma_f32_32x32x16_bf16(__builtin_bit_cast(bf16x8, aw), __builtin_bit_cast(bf16x8, bw), cacc, 0, 0, 0);
                    }
        #pragma unroll
                    for (int r = 0; r < 16; ++r) WQC[(size_t)(hp * 128 + mt * 32 + att::crow(r, hi2)) * 1024 + ntile * 32 + r32] = (bf16_t)(cvtpk(cacc[r], 0.f) & 0xffffu);
                }
                LAS float* scr = (LAS float*)(lds + wave * 16384);
                constexpr int I_IN = 16 * (INW / 32), I_SQ = 16 * 32;
                for (int it = gw; it < I_IN + 2 * I_SQ; it += NGW) {
                    int r = it;
                    if (r < I_IN) { p0_transpose_item(w_in, 1024, INW, WIN, scr, r, lane, 0, ln_mix_g, true);   continue; } r -= I_IN;
                    if (r < I_SQ) { p0_transpose_item(w_attn_up, 1024, 1024, WUP, scr, r, lane, 1536);   continue; } r -= I_SQ;
                    p0_transpose_item(w_o, 1024, 1024, WO, scr, r, lane, 0, nullptr, false, W8_SCALE);
                }
                for (int id = gt; id < 131072; id += NGT) {
                    const int n = id & 1023, kq = id >> 10, g = kq >> 5, c0 = (kq & 31) * 4;
                    float a4[4] = {0.f, 0.f, 0.f, 0.f};
        #pragma unroll 8
                    for (int d = 0; d < 128; ++d) { const float s = pool_scale[g * 128 + d] * w_pool_up[(size_t)(g * 128 + d) * 1024 + n];
        #pragma unroll
                        for (int i = 0; i < 4; ++i) a4[i] += w_pool_grp[(size_t)(g * 128 + c0 + i) * 128 + d] * s; }
                    u32x2 w; w.x = cvtpk(a4[0], a4[1]); w.y = cvtpk(a4[2], a4[3]);
                    *(u32x2*)(WUP + (size_t)n * 1536 + 1024 + g * 128 + c0) = w;
                }
            } else {
                for (int r0 = gw; r0 < 2 * NEXP; r0 += 4 * NGW) {
                    const float* sp[4]; unsigned char* dp[4]; float* ip[4]; int u4[4];
        #pragma unroll
                    for (int i = 0; i < 4; ++i) { int r = r0 + i * NGW; if (r >= 2 * NEXP) r = r0; const int e = r & (NEXP - 1);
                        u4[i] = (r < NEXP) ? 1 : 2; sp[i] = ((r < NEXP) ? u_exp : v_exp) + (size_t)e * 1024; dp[i] = ((r < NEXP) ? UT : VT) + (size_t)e * 128; ip[i] = SCU + 2 * e + ((r < NEXP) ? 0 : 1); }
                    fp8_rows<4, true>(sp, dp, ip, lane, u4);
                }
                for (int m = gw; m < T; m += 4 * NGW) rms_rows_to_bf16<4, float>(x + (size_t)m * D, (size_t)NGW * D, nullptr, (bf16_t*)nullptr, lane, XH8 + (size_t)m * D, XS0 + m, (size_t)NGW, IRS + m, true);
            }
        }
    }
    SEAM(0);
    PH(1) if (IN(1)) {
        for (int n = gw; n < INW + 1024; n += NGW) {
            if (n < INW) quant_row_i8(WIN + (size_t)n * 1024, WIN8 + (size_t)n * 1024, SWIN + n, lane);
            else { const int m = n - INW;
                const float s0 = quant_row_i8(WUP + (size_t)m * 1536, WC8 + (size_t)m * 1536, SWC0 + m, lane), s1 = quant_row512_i8(WUP + (size_t)m * 1536 + 1024, WC8 + (size_t)m * 1536 + 1024, SWC1 + m, lane);
                if (lane == 0) SWCR[m] = (AO_CLIP / 127.f) * s0 / fmaxf(s1, 1e-30f); } }
        xcd_barrier(xbar);
        pg8::Gemm g{(const bf16_t*)XH8, (const bf16_t*)WIN8, T, INW, 1024}; pg8::StaticOrder S; S.init(T, INW, G, bx, GREP(1), 1024, 0, 1);
        pg8::Epi8<FIn> E{FIn{QB, KVB, PZ, SGA, SGP, b_in, SWIN, XS0}};
        pg8::gemm_phase<pg8::Epi8<FIn>, pg8::StaticOrder, true, true, 1, true>(lds, g, S, E);
    }
    SEAM(1);
    PH(2) if (IN(2)) {
        for (int rep2 = 0; rep2 < PROBE_ATT; ++rep2)
        for (int u = bx; u < NB * 2 * 4; u += G) { const int rn = u & 3, kvh = (u >> 2) & 1, b = u >> 3; att::run(lds, QB, KVB, AOP, 1536, sinks, b, kvh, rn); }
        for (int id = gt; id < (T / 32) * 64; id += NGT) {
            const int c8 = (id & 63) * 8, ta = (id >> 6) * 32, pos0 = ta & (SEQ - 1), w = 2 << (c8 >> 7);
            const bf16_t* pzc = PZ + c8; unsigned char* plc = (unsigned char*)AOP + 1024 + c8;
            float sw[8] = {0.f, 0.f, 0.f, 0.f, 0.f, 0.f, 0.f, 0.f};
            {
                u32x4 pre[16];
#pragma unroll
                for (int i = 0; i < 16; ++i) { const bool ok = (i < w) && (pos0 - 1 - i >= 0); pre[i] = *(const u32x4*)(pzc + (size_t)(ok ? ta - 1 - i : ta) * 512); }
#pragma unroll
                for (int i = 0; i < 16; ++i) { const float m = ((i < w) && (pos0 - 1 - i >= 0)) ? 1.f : 0.f; float v[8]; unpack8(pre[i], v);
#pragma unroll
                    for (int e = 0; e < 8; ++e) sw[e] += m * v[e]; }
            }
            for (int blk = 0; blk < 4; ++blk) {
                const int tb = ta + blk * 8, pb = pos0 + blk * 8;
                u32x4 cur[8], lag[8];
#pragma unroll
                for (int i = 0; i < 8; ++i) cur[i] = *(const u32x4*)(pzc + (size_t)(tb + i) * 512);
#pragma unroll
                for (int i = 0; i < 8; ++i) { const bool ok = (pb + i - w >= 0); lag[i] = *(const u32x4*)(pzc + (size_t)(ok ? tb + i - w : tb + i) * 512); }
#pragma unroll
                for (int i = 0; i < 8; ++i) {
                    const int pos = pb + i; const float m = (pos - w >= 0) ? 1.f : 0.f;
                    float v[8], z[8]; unpack8(cur[i], v); unpack8(lag[i], z);
                    const float ic = __builtin_amdgcn_rcpf((float)((pos + 1 < w) ? pos + 1 : w));
                    float o8[8];
#pragma unroll
                    for (int e = 0; e < 8; ++e) { sw[e] += v[e] - m * z[e]; o8[e] = sw[e] * ic - v[e]; }
                    float pm_ = 0.f;
#pragma unroll
                    for (int e = 0; e < 8; ++e) pm_ = fmaxf(pm_, fabsf(o8[e]));
                    pm_ = fmaxf(wave_max(pm_), 0.127f);
                    const float ps_ = 127.f / pm_;
                    unsigned q8[8];
#pragma unroll
                    for (int e = 0; e < 8; ++e) q8[e] = (unsigned)__float2int_rn(o8[e] * ps_) & 0xffu;
                    u32x2 pw; pw.x = q8[0] | (q8[1] << 8) | (q8[2] << 16) | (q8[3] << 24); pw.y = q8[4] | (q8[5] << 8) | (q8[6] << 16) | (q8[7] << 24);
                    *(u32x2*)(plc + (size_t)(tb + i) * 1536) = pw;
                    if (lane == 0) SPL[tb + i] = pm_ * (1.f / 127.f);
                }
            }
        }
    }
    SEAM(2);
    PH(3) if (IN(3)) {
        pg8::Gemm g{AOP, (const bf16_t*)WC8, T, 1024, 1536}; pg8::StaticOrder S; S.init(T, 1024, G, bx, GREP(3), 1024, 512, 1);
        pg8::Epi8<FMerge> E{FMerge{SGA, SGP, MRG, SPL, SWCR, SWC1}};
        pg8::gemm_phase<pg8::Epi8<FMerge>, pg8::StaticOrder, true, true, 1, true>(lds, g, S, E);
    }
    SEAM(3);
    PH(4) if (IN(4)) {
        pg8::Gemm g{MRG, WO, T, 1024, 1024}; pg8::StaticOrder S; S.init(T, 1024, G, bx, GREP(4), 1024, 0, 1);
        pg8::Epi8<FRes> E{FRes{XH8, IRS, H, XS0}};
        pg8::gemm_phase<pg8::Epi8<FRes>, pg8::StaticOrder, true, true, 1>(lds, g, S, E);
    }
    SEAM(4);
    PH(5) if (IN(5)) { for (int n = gw; n < 2048; n += NGW) quant_row_i8(WQC + (size_t)n * 1024, WQ8 + (size_t)n * 1024, SWQ + n, lane);
        for (int m = gw; m < T; m += 4 * NGW) rms_rows_to_bf16<4, bf16_t>(H + (size_t)m * D, (size_t)NGW * D, ln_ffn_g, (bf16_t*)nullptr, lane, X8 + (size_t)m * D, XS + m, (size_t)NGW, RS2 + m); }
    SEAM(5);
    PH(6) if (IN(6)) {
        pg8::Gemm g{(const bf16_t*)X8, (const bf16_t*)WQ8, T, 2048, 1024}; pg8::StaticOrder S; S.init(T, 2048, G, bx, GREP(6), 1024, 0, 1);
        pg8::Epi8<FQP> E{FQP{(unsigned short*)QP, XS, SWQ}};
        pg8::gemm_phase<pg8::Epi8<FQP>, pg8::StaticOrder, true, true, 1, true>(lds, g, S, E);
    }
    SEAM(6);
    PH(7) if (IN(7)) {
        const int q = lane & 31, hh = lane >> 5;
        LAS unsigned char* tb = lds + tid * 36;
        for (int tile = bx; tile < T / 256; tile += G) {
            const int tok = tile * 256 + wave * 32 + q;
            const unsigned short* qsb = (const unsigned short*)QP + (size_t)((tile * 8 + wave) * 16) * 4096 + lane * 8;
            u32x4 scn[8];
#pragma unroll
            for (int c = 0; c < 8; ++c) scn[c] = *(const u32x4*)(qsb + c * 512);
            for (int hd = 0; hd < 8; ++hd) {
                unsigned S0[16], S1[16];
#pragma unroll
                for (int p = 0; p < 2; ++p) {
                    u32x4 sc[8];
#pragma unroll
                    for (int c = 0; c < 8; ++c) sc[c] = scn[c];
                    { const int un = (hd * 2 + p + 1 < 16) ? hd * 2 + p + 1 : 15;
#pragma unroll
                      for (int c = 0; c < 8; ++c) scn[c] = *(const u32x4*)(qsb + (size_t)un * 4096 + c * 512); }
                    unsigned run[16];
#pragma unroll
                    for (int blk = 0; blk < 4; ++blk) {
                        unsigned nw[16];
#pragma unroll
                        for (int dw = 0; dw < 8; ++dw) { const int c = 2 * blk + (dw >> 2), e = (dw & 3) * 2;
                            const unsigned wd = (dw & 3) == 0 ? sc[c].x : (dw & 3) == 1 ? sc[c].y : (dw & 3) == 2 ? sc[c].z : sc[c].w;
                            const unsigned x = tk::okey16x2(wd);
                            nw[2 * dw] = (x << 16) | (unsigned)(127 - (64 * hh + 8 * c + e));
                            nw[2 * dw + 1] = (x & 0xffff0000u) | (unsigned)(127 - (64 * hh + 8 * c + e + 1)); }
                        tk::sort16(nw);
                        if (blk == 0) {
#pragma unroll
                            for (int i = 0; i < 16; ++i) run[i] = nw[i];
                        } else tk::merge16(run, nw);
                    }
                    tk::merge16_xlane(run);
#pragma unroll
                    for (int i = 0; i < 16; ++i) { if (p == 0) S0[i] = run[i]; else S1[i] = run[i]; }
                }
#pragma unroll
                for (int w4 = 0; w4 < 4; ++w4) {
                    *(LAS unsigned*)(tb + 4 * w4) = (127u - (S0[4 * w4] & 127u)) | ((127u - (S0[4 * w4 + 1] & 127u)) << 8) | ((127u - (S0[4 * w4 + 2] & 127u)) << 16) | ((127u - (S0[4 * w4 + 3] & 127u)) << 24);
                    *(LAS unsigned*)(tb + 16 + 4 * w4) = (127u - (S1[4 * w4] & 127u)) | ((127u - (S1[4 * w4 + 1] & 127u)) << 8) | ((127u - (S1[4 * w4 + 2] & 127u)) << 16) | ((127u - (S1[4 * w4 + 3] & 127u)) << 24);
                }
                float va[16], vb[16];
#pragma unroll
                for (int i = 0; i < 16; ++i) { va[i] = tk::ofloat16(S0[i]); vb[i] = tk::ofloat16(S1[i]); }
                { const float a15 = va[15], b15 = vb[15];
#pragma unroll
                  for (int i = 0; i < 16; ++i) { va[i] -= a15; vb[i] -= b15; } }
                unsigned C[16];
#pragma unroll
                for (int j = 0; j < 16; ++j) C[j] = (__float_as_uint(va[0] + vb[j]) & ~255u) | (unsigned)(255 - j);
                {
                    unsigned g1[16], g2[16], g3[16];
#define CAND(i, j) ((__float_as_uint(va[i] + vb[j]) & ~255u) | (unsigned)(255 - ((i) * 16 + (j))))
                    g1[0] = CAND(1, 0); g1[1] = CAND(1, 1); g1[2] = CAND(1, 2); g1[3] = CAND(1, 3); g1[4] = CAND(1, 4); g1[5] = CAND(1, 5); g1[6] = CAND(1, 6); g1[7] = CAND(1, 7);
                    g1[8] = CAND(2, 0); g1[9] = CAND(2, 1); g1[10] = CAND(2, 2); g1[11] = CAND(2, 3); g1[12] = CAND(2, 4); g1[13] = CAND(3, 0); g1[14] = CAND(3, 1); g1[15] = CAND(3, 2);
                    g2[0] = CAND(3, 3); g2[1] = CAND(4, 0); g2[2] = CAND(4, 1); g2[3] = CAND(4, 2); g2[4] = CAND(5, 0); g2[5] = CAND(5, 1); g2[6] = CAND(6, 0); g2[7] = CAND(6, 1);
                    g2[8] = CAND(7, 0); g2[9] = CAND(7, 1); g2[10] = CAND(8, 0); g2[11] = CAND(9, 0); g2[12] = CAND(10, 0); g2[13] = CAND(11, 0); g2[14] = CAND(12, 0); g2[15] = CAND(13, 0);
                    g3[0] = CAND(14, 0); g3[1] = CAND(15, 0);
#pragma unroll
                    for (int i = 2; i < 16; ++i) g3[i] = 0u;
#undef CAND
                    tk::sort16(g1); tk::merge16(C, g1);
                    tk::sort16(g2); tk::merge16(C, g2);
                    tk::ce(g3[0], g3[1]); tk::merge16(C, g3);
                }
                const float smax = __uint_as_float(C[0] & ~255u);
                float ev[8]; unsigned ei[8]; float esum = 0.f; const unsigned hmask = 0u - (unsigned)hh;
                asm volatile("s_waitcnt lgkmcnt(0)" ::: "memory");
#pragma unroll
                for (int m = 0; m < 8; ++m) {
                    const unsigned key = C[m] ^ ((C[m] ^ C[8 + m]) & hmask);
                    const unsigned f = 255u - (key & 255u);
                    const unsigned ia = tb[f >> 4], ib = tb[16 + (f & 15u)];
                    ei[m] = ia * 128u + ib;
                    ev[m] = __builtin_amdgcn_exp2f((__uint_as_float(key & ~255u) - smax) * LOG2E); esum += ev[m];
                }
                esum += __shfl_xor(esum, 32);
                const float rden = 1.f / esum;
                u32x4 ew; ew.x = ei[0] | (ei[1] << 16); ew.y = ei[2] | (ei[3] << 16); ew.z = ei[4] | (ei[5] << 16); ew.w = ei[6] | (ei[7] << 16);
                *(u32x4*)(EID + (size_t)tok * 128 + hd * 16 + hh * 8) = ew;
                { u32x4 gw; gw.x = cvtpk(ev[0] * rden, ev[1] * rden); gw.y = cvtpk(ev[2] * rden, ev[3] * rden); gw.z = cvtpk(ev[4] * rden, ev[5] * rden); gw.w = cvtpk(ev[6] * rden, ev[7] * rden);
                  *(u32x4*)(GSM + (size_t)tok * 128 + hd * 16 + hh * 8) = gw; }
            }
        }
    }
    SEAM(7);
    PH(8) if (IN(8)) {
        const int cb = (bx & 7) >> 1, hf = bx & 1, c = lane & 7, j = lane >> 3;
        const unsigned char* ubase = UT + (size_t)cb * (NEXP * 128);
        const unsigned c16 = (unsigned)c * 16u;
        LAS int* red = (LAS int*)(lds + wave * 5120);
        unsigned short* pbase = PART + (size_t)cb * T * 128 + 2 * lane;
#define P8_ISSUE(RR, E0, E1) do { const unsigned ew_[8] = {E0.x, E0.y, E0.z, E0.w, E1.x, E1.y, E1.z, E1.w}; \
            _Pragma("unroll") for (int i_ = 0; i_ < 8; ++i_) { \
                const unsigned o0_ = ((ew_[i_] << 7) & 0x7fff80u) | c16, o1_ = ((ew_[i_] >> 9) & 0x7fff80u) | c16;     \
                RR[2 * i_] = *(const u32x4*)(ubase + o0_); RR[2 * i_ + 1] = *(const u32x4*)(ubase + o1_); } } while (0)
#define P8_COMPUTE(RR, XA, XH, XSV, TT) do { int ds[16]; \
            _Pragma("unroll") for (int i_ = 0; i_ < 16; ++i_) { int h = 0; \
                h = __builtin_amdgcn_sdot8((int)RR[i_].x, (int)XH.x, h, false); h = __builtin_amdgcn_sdot8((int)RR[i_].y, (int)XH.y, h, false); \
                h = __builtin_amdgcn_sdot8((int)RR[i_].z, (int)XH.z, h, false); h = __builtin_amdgcn_sdot8((int)RR[i_].w, (int)XH.w, h, false); \
                int a = h << 4;     \
                a = __builtin_amdgcn_sdot8((int)RR[i_].x, (int)XA.x, a, false); a = __builtin_amdgcn_sdot8((int)RR[i_].y, (int)XA.y, a, false); \
                a = __builtin_amdgcn_sdot8((int)RR[i_].z, (int)XA.z, a, false); a = __builtin_amdgcn_sdot8((int)RR[i_].w, (int)XA.w, a, false); \
                ds[i_] = a; } \
              \
            { typedef int i32x4_t __attribute__((ext_vector_type(4))); typedef int i32x2_t __attribute__((ext_vector_type(2))); \
              LAS i32x4_t* rw_ = (LAS i32x4_t*)(red + lane * 20); rw_[0] = (i32x4_t){ds[0], ds[1], ds[2], ds[3]}; rw_[1] = (i32x4_t){ds[4], ds[5], ds[6], ds[7]}; rw_[2] = (i32x4_t){ds[8], ds[9], ds[10], ds[11]}; rw_[3] = (i32x4_t){ds[12], ds[13], ds[14], ds[15]}; \
              i32x2_t sm_ = (i32x2_t){0, 0}; \
              _Pragma("unroll") for (int c2_ = 0; c2_ < 8; ++c2_) sm_ += *(const LAS i32x2_t*)(red + (j * 8 + c2_) * 20 + 2 * c); \
              ds[0] = sm_.x; ds[1] = sm_.y; } \
            const float xs_ = (XSV) * 0.015625f; \
            { typedef _Float16 h2_t __attribute__((ext_vector_type(2))); const h2_t hv_ = __builtin_convertvector((f32x2_t){(float)ds[0] * xs_, (float)ds[1] * xs_}, h2_t);     \
              *(unsigned*)(pbase + (size_t)(TT) * 128) = __builtin_bit_cast(unsigned, hv_); } } while (0)
        LAS unsigned char* estg = lds + 40960 + wave * 2048;
#define P8_EIDS(E0, E1, U) do { E0 = *(const LAS u32x4*)(estg + ((U) & 7) * 256 + j * 32); E1 = *(const LAS u32x4*)(estg + ((U) & 7) * 256 + j * 32 + 16); } while (0)
        LAS unsigned char* xstg = lds + 98304 + wave * 1024;
        LAS unsigned char* xsth = lds + 57344 + wave * 1024;
        const signed char* xg8 = X8 + cb * 256 + (size_t)(lane >> 3) * 1024 + (lane & 7) * 16;
#define P8_PLANES(NX, NH) do { _Pragma("unroll") for (int d_ = 0; d_ < 4; ++d_) { const unsigned A_ = NX[d_], B_ = NH[d_]; \
            const unsigned A8_ = ((A_ & 0x7f7f7f7fu) + 0x08080808u) ^ (A_ & 0x80808080u), B8_ = ((B_ & 0x7f7f7f7fu) + 0x08080808u) ^ (B_ & 0x80808080u); \
            NX[d_] = (A_ & 0x0f0f0f0fu) | ((B_ & 0x0f0f0f0fu) << 4); NH[d_] = ((A8_ >> 4) & 0x0f0f0f0fu) | (B8_ & 0xf0f0f0f0u); } } while (0)
#define P8_XLD(U) (*(const LAS u32x4*)(xstg + ((U) & 7) * 128 + c * 16))
#define P8_XHD(U) (*(const LAS u32x4*)(xsth + ((U) & 7) * 128 + c * 16))
        LAS float* xsst = (LAS float*)(lds + 106496 + wave * 32);
#define P8_XSLD(U) (xsst[(U) & 7])
        for (int sh = bx >> 3; sh < 32; sh += (G >> 3)) {
            const int t0 = sh * 2048 + hf * 1024 + wave * 128, tl = t0 + 127;
            u32x4 rrA[16], rrB[16];
            const unsigned short* eg = EID + (size_t)t0 * 128 + lane * 16;
            u32x4 n0 = *(const u32x4*)eg, n1 = *(const u32x4*)(eg + 8);
            *(LAS u32x4*)(estg + lane * 32) = n0; *(LAS u32x4*)(estg + lane * 32 + 16) = n1;
            n0 = *(const u32x4*)(eg + 1024); n1 = *(const u32x4*)(eg + 1024 + 8);
            u32x4 nx = *(const u32x4*)(xg8 + (size_t)t0 * 1024), nh = *(const u32x4*)(xg8 + (size_t)t0 * 1024 + 128); float nxs = XS[t0 + (lane & 7)];
            P8_PLANES(nx, nh);
            *(LAS u32x4*)(xstg + lane * 16) = nx; *(LAS u32x4*)(xsth + lane * 16) = nh; xsst[lane & 7] = nxs;
            nx = *(const u32x4*)(xg8 + (size_t)(t0 + 8) * 1024); nh = *(const u32x4*)(xg8 + (size_t)(t0 + 8) * 1024 + 128); nxs = XS[t0 + 8 + (lane & 7)];
            u32x4 e0, e1;
            P8_EIDS(e0, e1, 0);
            u32x4 xA = P8_XLD(0), hA = P8_XHD(0); float sA = P8_XSLD(0);
            P8_ISSUE(rrA, e0, e1);
            u32x4 xB, hB; float sB;
            for (int tt = 0; tt < 128; tt += 2) {
                const int t = t0 + tt, t2 = (t + 2 < tl) ? t + 2 : tl;
                P8_EIDS(e0, e1, tt + 1); xB = P8_XLD(tt + 1); hB = P8_XHD(tt + 1); sB = P8_XSLD(tt + 1); P8_ISSUE(rrB, e0, e1);
                if ((tt & 7) == 6) {
                    P8_PLANES(nx, nh);
                    *(LAS u32x4*)(estg + lane * 32) = n0; *(LAS u32x4*)(estg + lane * 32 + 16) = n1; *(LAS u32x4*)(xstg + lane * 16) = nx; *(LAS u32x4*)(xsth + lane * 16) = nh; xsst[lane & 7] = nxs;
                    const int nb = ((tt >> 3) + 2 < 15) ? (tt >> 3) + 2 : 15;
                    n0 = *(const u32x4*)(eg + nb * 1024); n1 = *(const u32x4*)(eg + nb * 1024 + 8); nx = *(const u32x4*)(xg8 + (size_t)(t0 + nb * 8) * 1024); nh = *(const u32x4*)(xg8 + (size_t)(t0 + nb * 8) * 1024 + 128); nxs = XS[t0 + nb * 8 + (lane & 7)];
                }
                P8_COMPUTE(rrA, xA, hA, sA, t);
                P8_EIDS(e0, e1, t2 - t0); xA = P8_XLD(t2 - t0); hA = P8_XHD(t2 - t0); sA = P8_XSLD(t2 - t0); P8_ISSUE(rrA, e0, e1);
                P8_COMPUTE(rrB, xB, hB, sB, t + 1);
            }
        }
#undef P8_EIDS
#undef P8_XLD
#undef P8_XHD
#undef P8_PLANES
#undef P8_XSLD
#undef P8_ISSUE
#undef P8_COMPUTE
    }
    SEAM(8);
    PH(9) if (IN(9)) {
        typedef _Float16 h2_t __attribute__((ext_vector_type(2)));
#define P9_LOAD(PV, E2, G2, T0) do { _Pragma("unroll") for (int r = 0; r < 4; ++r) { const int t = (T0) + r * NGW; \
            _Pragma("unroll") for (int k = 0; k < 4; ++k) PV[r][k] = *(const unsigned*)(PART + ((size_t)k * T + t) * 128 + 2 * lane); \
            E2[r] = *(const unsigned*)(EID + (size_t)t * 128 + lane * 2); G2[r] = *(const unsigned*)(GSM + (size_t)t * 128 + lane * 2); } } while (0)
#define P9_SCALES(SC, E2) do { _Pragma("unroll") for (int r = 0; r < 4; ++r) { SC[r][0] = *(const f32x2_t*)(SCU + 2 * (E2[r] & 0xffffu)); SC[r][1] = *(const f32x2_t*)(SCU + 2 * (E2[r] >> 16)); } } while (0)
        unsigned pv[4][4], e2[4], g2[4], pvn[4][4], e2n[4], g2n[4]; f32x2_t sc[4][2], scn[4][2];
        int t0 = gw;
        if (t0 < T) { P9_LOAD(pv, e2, g2, t0); P9_SCALES(sc, e2); }
        for (; t0 < T; t0 += 4 * NGW) {
            const int tn = (t0 + 4 * NGW < T) ? t0 + 4 * NGW : t0;
            P9_LOAD(pvn, e2n, g2n, tn);
#pragma unroll
            for (int r = 0; r < 4; ++r) { const int t = t0 + r * NGW;
                f32x2_t p8[4];
#pragma unroll
                for (int k = 0; k < 4; ++k) p8[k] = __builtin_convertvector(__builtin_bit_cast(h2_t, pv[r][k]), f32x2_t);
                const f32x2_t sm = (p8[0] + p8[1]) + (p8[2] + p8[3]);
                const float w0 = bf_lo(g2[r]) * gelu_erf(sm.x * (sc[r][0].x * 64.f)) * sc[r][0].y, w1 = bf_hi(g2[r]) * gelu_erf(sm.y * (sc[r][1].x * 64.f)) * sc[r][1].y;
                float am = fmaxf(fabsf(w0), fabsf(w1));
#pragma unroll
                for (int o = 1; o < 64; o <<= 1) am = fmaxf(am, __shfl_xor(am, o));
                const float qs = am > 0.f ? 127.f / am : 0.f;
                const int q0 = __float2int_rn(w0 * qs), q1 = __float2int_rn(w1 * qs);
                *(unsigned short*)(GS8 + (size_t)t * 128 + lane * 2) = (unsigned short)((q0 & 0xff) | ((q1 & 0xff) << 8));
                int sq_ = q0 + q1;
#pragma unroll
                for (int o = 1; o < 64; o <<= 1) sq_ += __shfl_xor(sq_, o);
                if (lane == 0) { WSC[t] = am * (1.f / 127.f); WSB[t] = -8.f * (float)sq_ * (am * (1.f / 127.f)); } }
            P9_SCALES(scn, e2n);
#pragma unroll
            for (int r = 0; r < 4; ++r) { e2[r] = e2n[r]; g2[r] = g2n[r]; sc[r][0] = scn[r][0]; sc[r][1] = scn[r][1];
#pragma unroll
                for (int k = 0; k < 4; ++k) pv[r][k] = pvn[r][k]; }
        }
#undef P9_LOAD
#undef P9_SCALES
    }
    SEAM(9);
    PH(10) if (IN(10)) {
        const int cb = (bx & 7) >> 1, hf = bx & 1, c = lane & 7, j = lane >> 3;
        const unsigned char* vbase = VT + (size_t)cb * (NEXP * 128);
        const unsigned c16 = (unsigned)c * 16u;
        const int col = cb * 256 + c * 16 + 2 * j;
        LAS unsigned char* estg = lds + 139264 + wave * 2048;
#define P10_EIDS(E0, E1, U) do { E0 = *(const LAS u32x4*)(estg + ((U) & 7) * 256 + j * 32); E1 = *(const LAS u32x4*)(estg + ((U) & 7) * 256 + j * 32 + 16); } while (0)
        LAS unsigned* ybuf = (LAS unsigned*)(lds + wave * 12288);
        LAS float* sqbuf = (LAS float*)(lds + wave * 12288 + 8192);
        LAS int* red = (LAS int*)(lds + 98304 + wave * 5120);
        const f32x2_t gfin = *(const f32x2_t*)(ln_final_g + col), gfinh = *(const f32x2_t*)(ln_final_g + col + 128);
        typedef int i32x4_t __attribute__((ext_vector_type(4))); typedef int i32x2_t __attribute__((ext_vector_type(2)));
        unsigned sello[4], selhi[4];
#pragma unroll
        for (int s_ = 0; s_ < 4; ++s_) { const unsigned z = 0x0c0c0c0cu, one = z ^ ((0x0cu ^ (unsigned)s_) << (8 * (c & 3))); sello[s_] = (c < 4) ? one : z; selhi[s_] = (c < 4) ? z : one; }
        const int rdo = (((j >> 1) & 1) * 16 + c) * 8 + (j >> 2) * 4 + (j & 1) * 2;
#define P10_ISSUE(RR, E0, E1) do { const unsigned ew_[8] = {E0.x, E0.y, E0.z, E0.w, E1.x, E1.y, E1.z, E1.w}; \
            _Pragma("unroll") for (int i_ = 0; i_ < 8; ++i_) { \
                const unsigned o0_ = ((ew_[i_] << 7) & 0x7fff80u) | c16, o1_ = ((ew_[i_] >> 9) & 0x7fff80u) | c16; \
                RR[2 * i_] = *(const u32x4*)(vbase + o0_); RR[2 * i_ + 1] = *(const u32x4*)(vbase + o1_); } } while (0)
        LAS unsigned char* wstg = lds + 98304 + wave * 5120 + 2048;
#define P10_WLD(U) (*(const LAS u32x4*)(wstg + ((U) & 7) * 128 + j * 16))
        LAS unsigned char* hstg = lds + 98304 + wave * 5120 + 3072;
        LAS unsigned char* hsth = lds + wave * 12288 + 10240;
        LAS float* wsst = (LAS float*)(lds + 155648 + 256 + wave * 32);
#define P10_HLD(U) (*(const LAS unsigned*)(hstg + ((U) & 7) * 256 + c * 32 + j * 4))
#define P10_HHD(U) (*(const LAS unsigned*)(hsth + ((U) & 7) * 256 + c * 32 + j * 4))
#define P10_WSLD(U) (wsst[(U) & 7])
        LAS float* wssb = (LAS float*)(lds + 156160 + wave * 32);
#define P10_WBLD(U) (wssb[(U) & 7])
#define P10_COMPUTE(RR, W, WS_, WB_, H2, H2H, TT, SLOT) do { i32x4_t a1_ = (i32x4_t){0, 0, 0, 0}, a2_ = (i32x4_t){0, 0, 0, 0}, a3_ = (i32x4_t){0, 0, 0, 0}, a4_ = (i32x4_t){0, 0, 0, 0}; \
            const unsigned wd_[4] = {W.x, W.y, W.z, W.w}; \
            _Pragma("unroll") for (int i_ = 0; i_ < 16; ++i_) { \
                const unsigned alo_ = __builtin_amdgcn_perm(wd_[i_ >> 2], wd_[i_ >> 2], sello[i_ & 3]), ahi_ = __builtin_amdgcn_perm(wd_[i_ >> 2], wd_[i_ >> 2], selhi[i_ & 3]); \
                const long av_ = (long)(((unsigned long)ahi_ << 32) | alo_); \
                const unsigned rx_ = RR[i_].x, ry_ = RR[i_].y, rz_ = RR[i_].z, rw2_ = RR[i_].w; \
                const long b1_ = (long)(((unsigned long)ry_ << 32) | rx_), b2_ = (long)(((unsigned long)rw2_ << 32) | rz_);     \
                const long b3_ = (long)(((unsigned long)(ry_ & 0xf0f0f0f0u) << 32) | (rx_ & 0xf0f0f0f0u)), b4_ = (long)(((unsigned long)(rw2_ & 0xf0f0f0f0u) << 32) | (rz_ & 0xf0f0f0f0u)); \
                a1_ = __builtin_amdgcn_mfma_i32_16x16x32_i8(av_, b1_, a1_, 0, 0, 0); a2_ = __builtin_amdgcn_mfma_i32_16x16x32_i8(av_, b2_, a2_, 0, 0, 0); \
                a3_ = __builtin_amdgcn_mfma_i32_16x16x32_i8(av_, b3_, a3_, 0, 0, 0); a4_ = __builtin_amdgcn_mfma_i32_16x16x32_i8(av_, b4_, a4_, 0, 0, 0); } \
              \
            { LAS i32x4_t* rw_ = (LAS i32x4_t*)(red + lane * 8); const float ws16_ = (WS_) * 0.0625f; \
              rw_[0] = a1_ - a3_; rw_[1] = a2_ - a4_; \
              const i32x2_t sa_ = *(const LAS i32x2_t*)(red + rdo), sb_ = *(const LAS i32x2_t*)(red + rdo + 40 * 8); \
              rw_[0] = a3_; rw_[1] = a4_; \
              const i32x2_t sc_ = *(const LAS i32x2_t*)(red + rdo), sd_ = *(const LAS i32x2_t*)(red + rdo + 40 * 8); \
              const f32x2_t y = (f32x2_t){(bf_lo(H2) + (WB_)) + (float)(sa_.x + sb_.x) * (WS_), (bf_hi(H2) + (WB_)) + (float)(sa_.y + sb_.y) * (WS_)}; \
              const f32x2_t yh = (f32x2_t){bf_lo(H2H) + (float)(sc_.x + sd_.x) * ws16_, bf_hi(H2H) + (float)(sc_.y + sd_.y) * ws16_}; \
              ybuf[(SLOT) * 128 + lane] = cvtpk(y.x, y.y); ybuf[(SLOT) * 128 + 64 + lane] = cvtpk(yh.x, yh.y); \
              sqbuf[((SLOT) & 7) * 64 + lane] = (y.x * y.x + y.y * y.y) + (yh.x * yh.x + yh.y * yh.y); } } while (0)
        unsigned long long* SS64 = (unsigned long long*)SS;
#define P10_FINAL(TB, SB) do { float rs_ = 1.f; \
            if (lane < 8) { unsigned long long v_; unsigned sp_ = 0; \
                while (((v_ = __hip_atomic_load(SS64 + (TB) + lane, __ATOMIC_RELAXED, __HIP_MEMORY_SCOPE_AGENT)) >> 48) < 4ull) { __builtin_amdgcn_s_sleep(2); if (++sp_ > (1u << 22)) break; } \
                rs_ = 1.f / sqrtf((float)(v_ & 0xffffffffffffull) * (1.f / 1048576.f) * (1.f / D) + EPS); } \
            _Pragma("unroll") for (int k_ = 0; k_ < 8; ++k_) { const float r_ = __uint_as_float(__builtin_amdgcn_readlane(__float_as_uint(rs_), k_)); const unsigned yw_ = ybuf[((SB) + k_) * 128 + lane], yv_ = ybuf[((SB) + k_) * 128 + 64 + lane]; \
                *(f32x2_t*)(out + (size_t)((TB) + k_) * 1024 + col) = (f32x2_t){bf_lo(yw_) * r_ * gfin.x, bf_hi(yw_) * r_ * gfin.y}; \
                *(f32x2_t*)(out + (size_t)((TB) + k_) * 1024 + col + 128) = (f32x2_t){bf_lo(yv_) * r_ * gfinh.x, bf_hi(yv_) * r_ * gfinh.y}; } } while (0)
        for (int sh = bx >> 3; sh < 32; sh += (G >> 3)) {
            const int t0 = sh * 2048 + hf * 1024 + wave * 128, tl = t0 + 127;
            u32x4 rrA[16], rrB[16]; u32x4 wA, wB; float sA, sB, bA, bB;
            const unsigned short* eg = EID + (size_t)t0 * 128 + lane * 16;
            u32x4 n0 = *(const u32x4*)eg, n1 = *(const u32x4*)(eg + 8);
            *(LAS u32x4*)(estg + lane * 32) = n0; *(LAS u32x4*)(estg + lane * 32 + 16) = n1;
            n0 = *(const u32x4*)(eg + 1024); n1 = *(const u32x4*)(eg + 1024 + 8);
            const signed char* wg8 = GS8 + (size_t)t0 * 128 + lane * 16;
            u32x4 nw = *(const u32x4*)wg8;
            const bf16_t* hg8 = H + (size_t)(t0 + (lane >> 3)) * 1024 + cb * 256 + (lane & 7) * 16;
            u32x4 nh0 = *(const u32x4*)hg8, nh1 = *(const u32x4*)(hg8 + 8), nh2 = *(const u32x4*)(hg8 + 128), nh3 = *(const u32x4*)(hg8 + 136); float nws = WSC[t0 + (lane & 7)], nwb = WSB[t0 + (lane & 7)];
            *(LAS u32x4*)(wstg + lane * 16) = nw; *(LAS u32x4*)(hstg + lane * 32) = nh0; *(LAS u32x4*)(hstg + lane * 32 + 16) = nh1; *(LAS u32x4*)(hsth + lane * 32) = nh2; *(LAS u32x4*)(hsth + lane * 32 + 16) = nh3; wsst[lane & 7] = nws; wssb[lane & 7] = nwb;
            nw = *(const u32x4*)(wg8 + 1024); nh0 = *(const u32x4*)(hg8 + 8 * 1024); nh1 = *(const u32x4*)(hg8 + 8 * 1024 + 8); nh2 = *(const u32x4*)(hg8 + 8 * 1024 + 128); nh3 = *(const u32x4*)(hg8 + 8 * 1024 + 136); nws = WSC[t0 + 8 + (lane & 7)]; nwb = WSB[t0 + 8 + (lane & 7)];
            u32x4 e0, e1;
            P10_EIDS(e0, e1, 0);
            wA = P10_WLD(0); sA = P10_WSLD(0); bA = P10_WBLD(0);
            unsigned hA = P10_HLD(0), gA = P10_HHD(0);
            P10_ISSUE(rrA, e0, e1);
            unsigned hB, gB;
            for (int tt = 0; tt < 128; tt += 2) {
                const int t = t0 + tt, t2 = (t + 2 < tl) ? t + 2 : tl;
                P10_EIDS(e0, e1, tt + 1); wB = P10_WLD(tt + 1); sB = P10_WSLD(tt + 1); bB = P10_WBLD(tt + 1); hB = P10_HLD(tt + 1); gB = P10_HHD(tt + 1); P10_ISSUE(rrB, e0, e1);
                if ((tt & 7) == 6) {
                    *(LAS u32x4*)(estg + lane * 32) = n0; *(LAS u32x4*)(estg + lane * 32 + 16) = n1; *(LAS u32x4*)(wstg + lane * 16) = nw;
                    *(LAS u32x4*)(hstg + lane * 32) = nh0; *(LAS u32x4*)(hstg + lane * 32 + 16) = nh1; *(LAS u32x4*)(hsth + lane * 32) = nh2; *(LAS u32x4*)(hsth + lane * 32 + 16) = nh3; wsst[lane & 7] = nws; wssb[lane & 7] = nwb;
                    const int nb = ((tt >> 3) + 2 < 15) ? (tt >> 3) + 2 : 15;
                    n0 = *(const u32x4*)(eg + nb * 1024); n1 = *(const u32x4*)(eg + nb * 1024 + 8); nw = *(const u32x4*)(wg8 + nb * 1024);
                    nh0 = *(const u32x4*)(hg8 + (size_t)nb * 8 * 1024); nh1 = *(const u32x4*)(hg8 + (size_t)nb * 8 * 1024 + 8); nh2 = *(const u32x4*)(hg8 + (size_t)nb * 8 * 1024 + 128); nh3 = *(const u32x4*)(hg8 + (size_t)nb * 8 * 1024 + 136); nws = WSC[t0 + nb * 8 + (lane & 7)]; nwb = WSB[t0 + nb * 8 + (lane & 7)];
                }
                P10_COMPUTE(rrA, wA, sA, bA, hA, gA, t, tt & 15);
                P10_EIDS(e0, e1, t2 - t0); wA = P10_WLD(t2 - t0); sA = P10_WSLD(t2 - t0); bA = P10_WBLD(t2 - t0); hA = P10_HLD(t2 - t0); gA = P10_HHD(t2 - t0); P10_ISSUE(rrA, e0, e1);
                P10_COMPUTE(rrB, wB, sB, bB, hB, gB, t + 1, (tt + 1) & 15);
                if ((tt & 7) == 6) {
                    const int b = tt >> 3;
                    { float sq16[16];
#pragma unroll
                      for (int k = 0; k < 16; ++k) sq16[k] = (k < 8) ? sqbuf[k * 64 + lane] : 0.f;
                      const float tot = reduce16(sq16, lane);
                      if ((lane & 3) == 0 && lane < 32) { const float fl_ = floorf(tot);
                          atomicAdd(SS64 + t0 + b * 8 + (lane >> 2), (1ull << 48) + ((unsigned long long)(unsigned)fl_ << 20) + (unsigned long long)(unsigned)((tot - fl_) * 1048576.f)); } }
                    if (b > 0) P10_FINAL(t0 + (b - 1) * 8, ((b - 1) & 1) * 8);
                }
            }
            P10_FINAL(t0 + 120, 8);
        }
#undef P10_ISSUE
#undef P10_EIDS
#undef P10_WLD
#undef P10_HLD
#undef P10_HHD
#undef P10_WSLD
#undef P10_WBLD
#undef P10_COMPUTE
#undef P10_FINAL
    }
#undef IN
#undef SEAM
}

#ifndef N_LAUNCHES
#define N_LAUNCHES 1
#endif
extern "C" void kernel_launch(void* const* d_in, const int* in_sizes, int n_in, void* d_out, int out_size, void* d_ws, size_t ws_size, hipStream_t stream) {
    static int grid = 0;
    if (grid == 0) {
        if (n_in != 16 || out_size != T * D || ws_size < WS_END) { fprintf(stderr, "kernel_launch: unexpected shapes: n_in %d out %d ws %zu\n", n_in, out_size, ws_size); grid = -1; return; }
        int dev = 0, cus = 0, per_cu = 0;
        (void)hipGetDevice(&dev); (void)hipDeviceGetAttribute(&cus, hipDeviceAttributeMultiprocessorCount, dev);
        (void)hipFuncSetAttribute((const void*)fwd, hipFuncAttributeMaxDynamicSharedMemorySize, LDS_BYTES);
        (void)hipOccupancyMaxActiveBlocksPerMultiprocessor(&per_cu, (const void*)fwd, 512, LDS_BYTES);
        (void)hipGetLastError();
        if (per_cu < 1) { fprintf(stderr, "kernel_launch: occupancy query says %d blocks/CU\n", per_cu); grid = -1; return; }
        grid = cus;
        fprintf(stderr, "kernel_launch: grid %d (cus %d, per_cu %d)\n", grid, cus, per_cu);
    }
    if (grid < 0) return;
    if (hipMemsetAsync((char*)d_ws + WS_CTL, 0, 1048576, stream) != hipSuccess) { fprintf(stderr, "kernel_launch: hipMemsetAsync failed\n"); return; }
    Args a{};
    for (int i = 0; i < 16; ++i) a.in[i] = (const float*)d_in[i];
    a.out = (float*)d_out; a.ws = (unsigned char*)d_ws;
    constexpr int NPH = 11;
    for (int li = 0; li < N_LAUNCHES; ++li) {
        a.ph_lo = (N_LAUNCHES == 1) ? 0 : li; a.ph_hi = (N_LAUNCHES == 1) ? NPH : li + 1;
        void* kargs[] = {&a};
        hipError_t e = hipLaunchCooperativeKernel((const void*)fwd, dim3(grid), dim3(512), kargs, LDS_BYTES, stream);
        if (e != hipSuccess) { fprintf(stderr, "kernel_launch: cooperative launch failed: %s (grid %d)\n", hipGetErrorString(e), grid); break; }
    }
}
```
